# Optimizing an MI355X kernel written in HIP

```python
import math
import jax, jax.numpy as jnp
from jax import lax
import numpy as np

D_MODEL = 2048
BATCH = 2
SEQ = 4096
DEPTH = 1
DEC_BATCH = 1
DEC_SEQ = 16384
PAST_LEN = 128

V_HEAD_DIM = 128
ATTN_WIDTH = D_MODEL // 2
N_HEADS = ATTN_WIDTH // V_HEAD_DIM
QK_NOPE_DIM = 128
QK_ROPE_DIM = 64
Q_LORA_RANK = 512
KV_LORA_RANK = 256
ROPE_THETA = 10000.0
Q_BLOCK = 128
SSM_WIDTH = D_MODEL - ATTN_WIDTH
SSM_GROUP = 16
N_SSM_GROUPS = SSM_WIDTH // SSM_GROUP
SSM_STATE = 64
N_DIR = 2
MIX_WIDTH = ATTN_WIDTH + SSM_WIDTH
IN_PROJ_WIDTH = Q_LORA_RANK + KV_LORA_RANK + QK_ROPE_DIM + SSM_WIDTH
D_FF = int(math.ceil(8 * D_MODEL / 3 / 256)) * 256
RMS_EPS = 1e-6

kernel_name = "hymba_mla_s5_sandwich_encoder"


def rms_norm(x, g):
    xf = x.astype(jnp.float32)
    y = xf * lax.rsqrt(jnp.mean(xf * xf, axis=-1, keepdims=True) + RMS_EPS)
    return (y * g.astype(jnp.float32)).astype(x.dtype)


def rope_tables(length):
    inv = 1.0 / (ROPE_THETA ** (jnp.arange(0, QK_ROPE_DIM, 2, dtype=jnp.float32) / QK_ROPE_DIM))
    ang = jnp.arange(length, dtype=jnp.float32)[:, None] * inv[None, :]
    return jnp.cos(ang), jnp.sin(ang)


def apply_rope(x, cos, sin):
    half = QK_ROPE_DIM // 2
    xf = x.astype(jnp.float32)
    x1, x2 = xf[..., :half], xf[..., half:]
    return jnp.concatenate([x1 * cos - x2 * sin, x2 * cos + x1 * sin], axis=-1).astype(x.dtype)


def mla_mixer(c_q, c_kv, k_rope, g_q_a, w_q_b, g_kv_a, w_kv_b):
    B, L, _ = c_q.shape
    q = (rms_norm(c_q, g_q_a) @ w_q_b).reshape(B, L, N_HEADS, QK_NOPE_DIM + QK_ROPE_DIM)
    q_nope, q_rope = q[..., :QK_NOPE_DIM], q[..., QK_NOPE_DIM:]
    kv = (rms_norm(c_kv, g_kv_a) @ w_kv_b).reshape(B, L, N_HEADS, QK_NOPE_DIM + V_HEAD_DIM)
    k_nope, v = kv[..., :QK_NOPE_DIM], kv[..., QK_NOPE_DIM:]
    cos, sin = rope_tables(L)
    q_rope = apply_rope(q_rope, cos[None, :, None, :], sin[None, :, None, :])
    k_rope = apply_rope(k_rope, cos[None], sin[None])
    scale = (QK_NOPE_DIM + QK_ROPE_DIM) ** -0.5
    n_blk = L // Q_BLOCK
    qn_blocks = (q_nope * scale).reshape(B, n_blk, Q_BLOCK, N_HEADS, QK_NOPE_DIM).transpose(1, 0, 2, 3, 4)
    qr_blocks = (q_rope * scale).reshape(B, n_blk, Q_BLOCK, N_HEADS, QK_ROPE_DIM).transpose(1, 0, 2, 3, 4)

    def attend_block(args):
        qn, qr = args
        s = (jnp.einsum('bqhd,bkhd->bhqk', qn, k_nope).astype(jnp.float32)
             + jnp.einsum('bqhr,bkr->bhqk', qr, k_rope).astype(jnp.float32))
        p = jax.nn.softmax(s, axis=-1).astype(v.dtype)
        return jnp.einsum('bhqk,bkhd->bqhd', p, v)

    out = lax.map(attend_block, (qn_blocks, qr_blocks))
    return out.transpose(1, 0, 2, 3, 4).reshape(B, L, N_HEADS * V_HEAD_DIM)


def _ssm_combine(e1, e2):
    a1, b1 = e1
    a2, b2 = e2
    return a1 * a2, a2 * b1 + b2


def s5_direction(u, lam_re, lam_im, log_dt, b_re, b_im, c_re, c_im, reverse):
    f32 = jnp.float32
    dt = jnp.exp(log_dt.astype(f32))[:, None]
    lam = lax.complex(lam_re.astype(f32), lam_im.astype(f32))
    lam_bar = jnp.exp(lam * dt)
    coef = (lam_bar - 1.0) / lam
    bu = lax.complex(jnp.einsum('gpc,blgc->blgp', b_re.astype(f32), u),
                     jnp.einsum('gpc,blgc->blgp', b_im.astype(f32), u)) * coef
    a = jnp.broadcast_to(lam_bar, bu.shape)
    _, xs = lax.associative_scan(_ssm_combine, (a, bu), axis=1, reverse=reverse)
    return (jnp.einsum('gcp,blgp->blgc', c_re.astype(f32), xs.real)
            - jnp.einsum('gcp,blgp->blgc', c_im.astype(f32), xs.imag))


def s5_mixer(u, lam_re, lam_im, log_dt, b_re, b_im, c_re, c_im, d_skip, w_glu, b_glu):
    B, L, _ = u.shape
    uf = u.astype(jnp.float32).reshape(B, L, N_SSM_GROUPS, SSM_GROUP)
    y = (s5_direction(uf, lam_re[0], lam_im[0], log_dt[0], b_re[0], b_im[0], c_re[0], c_im[0], False)
         + s5_direction(uf, lam_re[1], lam_im[1], log_dt[1], b_re[1], b_im[1], c_re[1], c_im[1], True)
         + d_skip.astype(jnp.float32) * uf)
    y = jax.nn.gelu(y.reshape(B, L, SSM_WIDTH)).astype(u.dtype)
    gate = jax.nn.sigmoid((y @ w_glu + b_glu).astype(jnp.float32))
    return (y.astype(jnp.float32) * gate).astype(u.dtype)


def encoder_layer(x, g_pre_mix, w_in, g_q_a, w_q_b, g_kv_a, w_kv_b,
                  ssm_lam_re, ssm_lam_im, ssm_log_dt, ssm_b_re, ssm_b_im, ssm_c_re, ssm_c_im,
                  ssm_d, w_glu, b_glu, g_out_attn, g_out_ssm, w_out, g_post_mix,
                  g_pre_ffn, w_gate, w_up, w_down, g_post_ffn):
    h = rms_norm(x, g_pre_mix)
    z = h @ w_in
    i0 = Q_LORA_RANK
    i1 = i0 + KV_LORA_RANK
    i2 = i1 + QK_ROPE_DIM
    c_q, c_kv, k_rope, u = z[..., :i0], z[..., i0:i1], z[..., i1:i2], z[..., i2:]
    a = mla_mixer(c_q, c_kv, k_rope, g_q_a, w_q_b, g_kv_a, w_kv_b)
    s = s5_mixer(u, ssm_lam_re, ssm_lam_im, ssm_log_dt, ssm_b_re, ssm_b_im, ssm_c_re, ssm_c_im,
                 ssm_d, w_glu, b_glu)
    m = jnp.concatenate([rms_norm(a, g_out_attn), rms_norm(s.astype(x.dtype), g_out_ssm)], axis=-1) @ w_out
    x = x + rms_norm(m, g_post_mix)
    h = rms_norm(x, g_pre_ffn)
    f = (jax.nn.silu(h @ w_gate) * (h @ w_up)) @ w_down
    return x + rms_norm(f, g_post_ffn)


def trunk(x, weights):
    for l in range(DEPTH):
        x = encoder_layer(x, *[w[l] for w in weights])
    return x


def setup_inputs(seed: int = 0) -> dict:
    key = jax.random.key(seed)
    ks = jax.random.split(key, 32)
    f32 = jnp.float32

    def nrm(k, shape, scale):
        return jax.random.normal(k, shape, f32) * scale

    def gain(k, shape):
        return 1.0 + 0.02 * jax.random.normal(k, shape, f32)

    G, P, C = N_SSM_GROUPS, SSM_STATE, SSM_GROUP
    n_idx = jnp.arange(P, dtype=f32)
    lam_re = -0.5 * jnp.exp(0.01 * jax.random.normal(ks[8], (DEPTH, N_DIR, G, P), f32))
    lam_im = math.pi * n_idx + 0.01 * jax.random.normal(ks[9], (DEPTH, N_DIR, G, P), f32)
    log_dt = jax.random.uniform(ks[10], (DEPTH, N_DIR, G), f32, math.log(1e-3), math.log(1e-1))
    return {
        "x_prompt": jax.random.normal(ks[0], (BATCH, SEQ, D_MODEL), f32),
        "x_sample": jax.random.normal(ks[1], (DEC_BATCH, DEC_SEQ, D_MODEL), f32),
        "g_pre_mix": gain(ks[2], (DEPTH, D_MODEL)),
        "w_in": nrm(ks[3], (DEPTH, D_MODEL, IN_PROJ_WIDTH), D_MODEL ** -0.5),
        "g_q_a": gain(ks[4], (DEPTH, Q_LORA_RANK)),
        "w_q_b": nrm(ks[5], (DEPTH, Q_LORA_RANK, N_HEADS * (QK_NOPE_DIM + QK_ROPE_DIM)), Q_LORA_RANK ** -0.5),
        "g_kv_a": gain(ks[6], (DEPTH, KV_LORA_RANK)),
        "w_kv_b": nrm(ks[7], (DEPTH, KV_LORA_RANK, N_HEADS * (QK_NOPE_DIM + V_HEAD_DIM)), KV_LORA_RANK ** -0.5),
        "ssm_lam_re": lam_re,
        "ssm_lam_im": lam_im,
        "ssm_log_dt": log_dt,
        "ssm_b_re": nrm(ks[11], (DEPTH, N_DIR, G, P, C), (2.0 * C) ** -0.5),
        "ssm_b_im": nrm(ks[12], (DEPTH, N_DIR, G, P, C), (2.0 * C) ** -0.5),
        "ssm_c_re": nrm(ks[13], (DEPTH, N_DIR, G, C, P), (2.0 * P) ** -0.5),
        "ssm_c_im": nrm(ks[14], (DEPTH, N_DIR, G, C, P), (2.0 * P) ** -0.5),
        "ssm_d": nrm(ks[15], (DEPTH, G, C), 1.0),
        "w_glu": nrm(ks[16], (DEPTH, SSM_WIDTH, SSM_WIDTH), SSM_WIDTH ** -0.5),
        "b_glu": nrm(ks[17], (DEPTH, SSM_WIDTH), 0.01),
        "g_out_attn": gain(ks[18], (DEPTH, ATTN_WIDTH)),
        "g_out_ssm": gain(ks[19], (DEPTH, SSM_WIDTH)),
        "w_out": nrm(ks[20], (DEPTH, MIX_WIDTH, D_MODEL), MIX_WIDTH ** -0.5),
        "g_post_mix": gain(ks[21], (DEPTH, D_MODEL)),
        "g_pre_ffn": gain(ks[22], (DEPTH, D_MODEL)),
        "w_gate": nrm(ks[23], (DEPTH, D_MODEL, D_FF), D_MODEL ** -0.5),
        "w_up": nrm(ks[24], (DEPTH, D_MODEL, D_FF), D_MODEL ** -0.5),
        "w_down": nrm(ks[25], (DEPTH, D_FF, D_MODEL), D_FF ** -0.5),
        "g_post_ffn": gain(ks[26], (DEPTH, D_MODEL)),
    }


def reference(x_prompt, x_sample, g_pre_mix, w_in, g_q_a, w_q_b, g_kv_a, w_kv_b,
              ssm_lam_re, ssm_lam_im, ssm_log_dt, ssm_b_re, ssm_b_im, ssm_c_re, ssm_c_im,
              ssm_d, w_glu, b_glu, g_out_attn, g_out_ssm, w_out, g_post_mix,
              g_pre_ffn, w_gate, w_up, w_down, g_post_ffn):
    weights = (g_pre_mix, w_in, g_q_a, w_q_b, g_kv_a, w_kv_b,
               ssm_lam_re, ssm_lam_im, ssm_log_dt, ssm_b_re, ssm_b_im, ssm_c_re, ssm_c_im,
               ssm_d, w_glu, b_glu, g_out_attn, g_out_ssm, w_out, g_post_mix,
               g_pre_ffn, w_gate, w_up, w_down, g_post_ffn)
    y_prompt = trunk(x_prompt, weights)
    y_sample = trunk(x_sample, weights)
    return (y_prompt, y_sample)
```

```cpp
#include <hip/hip_runtime.h>
#include <hip/hip_cooperative_groups.h>
#include <cstdint>
#include <cstdio>
namespace cg = cooperative_groups;

constexpr int DM = 2048, MROWS = 24576, MPROMPT = 8192, LP = 4096, LS = 16384;
constexpr int NH = 8, QKD = 192, DFF = 5632;
constexpr int TCH = 32, NCHUNK = MROWS / TCH  , NG = 64;
constexpr float RMS_EPS = 1e-6f;

namespace pg8 {
#define PG8_LAS __attribute__((address_space(3)))
typedef unsigned short bf16_t;
typedef short bf16x8 __attribute__((ext_vector_type(8)));
typedef float f32x4 __attribute__((ext_vector_type(4)));
typedef unsigned u32x4 __attribute__((ext_vector_type(4)));
constexpr int BM = 256, BK = 64, HALF = 128, HTB = HALF * BK * 2, STAGE_BYTES = 8 * HTB, NXCD = 8, WGM = 8;

__host__ __device__ __forceinline__ int lds_byte(int r, int c) { const int st = (r >> 4) * 2 + (c >> 5), rr = r & 15, cc = c & 31, ob = rr * 64 + cc * 2; return st * 1024 + (ob ^ (((ob >> 9) & 1) << 5)); }
__host__ __device__ __forceinline__ void stage_rc(int b, int& R, int& C) { const int st = b / 1024, sb = b % 1024, swz = sb ^ (((sb >> 9) & 1) << 5); R = (st >> 1) * 16 + swz / 64; C = (st & 1) * 32 + (swz % 64) / 2; }
__host__ __device__ __forceinline__ int perm32(int rho) { const int n = rho >> 4, i = rho & 15; return 8 * (i >> 2) + 4 * n + (i & 3); }

struct Unit { int pm, pn, g; };
struct Gemm { const bf16_t* A; const bf16_t* Bt; int lda, ldb, K; long gsA, gsB; };

struct StaticOrder {
    int nM, nN, nwg, G, c;
    __device__ void init(int M, int N, int G_, int c_) { nM = M / BM; nN = N / BM; nwg = nM * nN; G = G_; c = c_; }
    __device__ bool next(int i, Unit& u) const {
        const long L = (long)i * G + c; if (L >= nwg) return false;
        int wgid = (int)L; { const int q = nwg / NXCD, r = nwg % NXCD, xcd = wgid % NXCD, off = wgid / NXCD; wgid = (xcd < r ? xcd * (q + 1) : r * (q + 1) + (xcd - r) * q) + off; }
        const int nig = WGM * nN, gid = wgid / nig, fm = gid * WGM, gsz = (nM - fm) < WGM ? (nM - fm) : WGM;
        u.pm = fm + ((wgid % nig) % gsz); u.pn = (wgid % nig) / gsz; u.g = 0; return true;
    }
};
struct GroupOrder {
    int nM, nN, per, total, G, c;
    __device__ void init(int nM_, int nN_, int ng, int G_, int c_) { nM = nM_; nN = nN_; per = nM * nN; total = per * ng; G = G_; c = c_; }
    __device__ bool next(int i, Unit& u) const {
        const int L = i * G + c; if (L >= total) return false;
        u.g = L / per; const int r = L % per; u.pn = r / nM; u.pm = r % nM; return true;
    }
};

__device__ __forceinline__ unsigned cvt_pk_bf16(float lo, float hi) { unsigned r; asm volatile("v_cvt_pk_bf16_f32 %0, %1, %2" : "=v"(r) : "v"(lo), "v"(hi)); return r; }
__device__ __forceinline__ u32x4 pack8(f32x4 v0, f32x4 v1) { u32x4 w; w.x = cvt_pk_bf16(v0[0], v0[1]); w.y = cvt_pk_bf16(v0[2], v0[3]); w.z = cvt_pk_bf16(v1[0], v1[1]); w.w = cvt_pk_bf16(v1[2], v1[3]); return w; }

template <class Epi, class Sched, bool ALIGN_EPI = true>
__device__ __forceinline__ void gemm_phase(PG8_LAS unsigned char* lds, const Gemm g, const Sched& S, const Epi& E) {
    int tid_ = threadIdx.x; asm volatile("" : "+v"(tid_));
    const int tid = tid_, wid = __builtin_amdgcn_readfirstlane(tid >> 6), lane = tid & 63, wr = wid >> 2, wc = wid & 3, fr = lane & 15, fq = lane >> 4;
    const int K = g.K, nt = K / BK;
    unsigned voffA[2], voffB[2];
#pragma unroll
    for (int i = 0; i < 2; ++i) { int R, C; stage_rc(tid * 16 + i * 8192, R, C); const int Rb = (R & ~31) + perm32(R & 31);
        voffA[i] = (unsigned)(R * g.lda + C) * 2u; voffB[i] = (unsigned)(Rb * g.ldb + C) * 2u; }
    const unsigned kstep = (unsigned)(BK * 2);
    const unsigned hstepA = (unsigned)(HALF * g.lda * 2), hstepB = (unsigned)(HALF * g.ldb * 2);
    const auto srdA = __builtin_amdgcn_make_buffer_rsrc((void*)g.A, (short)0, 0x7fffffff, 0x00020000);
    const auto srdB = __builtin_amdgcn_make_buffer_rsrc((void*)g.Bt, (short)0, 0x7fffffff, 0x00020000);
    const unsigned ldsw = (unsigned)wid * 1024u;
    const int aoff = lds_byte(wr * 64 + fr, fq * 8), boff = lds_byte(wc * 32 + fr, fq * 8);
#define PG8_SA(b, h) (((b) * 2 + (h)) * HTB)
#define PG8_SB(b, h) ((4 + (b) * 2 + (h)) * HTB)
#define PG8_STAGE(srd, bufoff, goff, voff) do { _Pragma("unroll") for (int _i = 0; _i < 2; ++_i) \
        __builtin_amdgcn_raw_ptr_buffer_load_lds(srd, (PG8_LAS unsigned*)(lds + (bufoff) + ldsw + _i * 8192), 16, (voff)[_i], (goff), 0, 0); } while (0)
#define PG8_LDA(dst, b, h) do { _Pragma("unroll") for (int m = 0; m < 4; ++m) _Pragma("unroll") for (int k = 0; k < 2; ++k) dst[m][k] = *(const PG8_LAS bf16x8*)(lds + PG8_SA(b, h) + aoff + m * 2048 + k * 1024); } while (0)
#define PG8_LDB(dst, b, h) do { _Pragma("unroll") for (int n = 0; n < 2; ++n) _Pragma("unroll") for (int k = 0; k < 2; ++k) dst[n][k] = *(const PG8_LAS bf16x8*)(lds + PG8_SB(b, h) + boff + n * 2048 + k * 1024); } while (0)
#define PG8_MMA(ai, bj, At, Bt) do { __builtin_amdgcn_s_setprio(1); _Pragma("unroll") for (int m = 0; m < 4; ++m) _Pragma("unroll") for (int n = 0; n < 2; ++n) _Pragma("unroll") for (int k = 0; k < 2; ++k) \
        acc[ai][bj][m][n] = __builtin_amdgcn_mfma_f32_16x16x32_bf16(Bt[n][k], At[m][k], acc[ai][bj][m][n], 0, 0, 0); __builtin_amdgcn_s_setprio(0); } while (0)
#define PG8_WAIT_V(n) asm volatile("s_waitcnt vmcnt(" #n ")" ::: "memory")
#define PG8_WAIT_L(n) asm volatile("s_waitcnt lgkmcnt(" #n ")" ::: "memory")
#define PG8_BAR __builtin_amdgcn_s_barrier()
#define PG8_SCHED __builtin_amdgcn_sched_barrier(0)
#define PG8_BASEA(u) ((unsigned)(((size_t)(u).g * g.gsA + (size_t)(u).pm * BM * g.lda) * 2))
#define PG8_BASEB(u) ((unsigned)(((size_t)(u).g * g.gsB + (size_t)(u).pn * BM * g.ldb) * 2))
    Unit cur, nxt; int ui = 0;
    if (!S.next(0, cur)) return;
    f32x4 acc[2][2][4][2];
#pragma unroll
    for (int a = 0; a < 2; ++a)
#pragma unroll
        for (int b = 0; b < 2; ++b)
#pragma unroll
            for (int m = 0; m < 4; ++m)
#pragma unroll
                for (int n = 0; n < 2; ++n) acc[a][b][m][n] = (f32x4){0.f, 0.f, 0.f, 0.f};
    bf16x8 At[4][2], B0[2][2], B1[2][2];
    unsigned cA = PG8_BASEA(cur), cB = PG8_BASEB(cur);
    PG8_STAGE(srdB, PG8_SB(0, 0), cB, voffB); PG8_STAGE(srdB, PG8_SB(0, 1), cB + hstepB, voffB); PG8_STAGE(srdA, PG8_SA(0, 0), cA, voffA); PG8_STAGE(srdA, PG8_SA(0, 1), cA + hstepA, voffA);
    if (wr == 1) PG8_BAR;
    PG8_WAIT_V(2); PG8_BAR;
    PG8_STAGE(srdB, PG8_SB(1, 0), cB + kstep, voffB); PG8_STAGE(srdA, PG8_SA(1, 0), cA + kstep, voffA); PG8_STAGE(srdB, PG8_SB(1, 1), cB + hstepB + kstep, voffB);
    PG8_WAIT_V(6); PG8_BAR;
    for (;;) {
        const bool has_next = S.next(ui + 1, nxt);
        const unsigned nA = has_next ? PG8_BASEA(nxt) : cA, nB = has_next ? PG8_BASEB(nxt) : cB;
        for (int t = 0; t < nt; t += 2) {
            if constexpr (Epi::MID) { if (t == (nt >> 1)) E.mid(acc, cur, wr, fr); }
            const bool last = (t == nt - 2);
            const unsigned a1 = cA + (unsigned)(t + 1) * kstep;
            const unsigned a2 = last ? nA : cA + (unsigned)(t + 2) * kstep, b2 = last ? nB : cB + (unsigned)(t + 2) * kstep;
            const unsigned a3 = a2 + kstep, b3 = b2 + kstep;
            PG8_LDB(B0, 0, 0); PG8_LDB(B1, 0, 1); PG8_SCHED; PG8_LDA(At, 0, 0); PG8_STAGE(srdA, PG8_SA(1, 1), a1 + hstepA, voffA);
            PG8_WAIT_V(8); PG8_WAIT_L(0); PG8_BAR; PG8_MMA(0, 0, At, B0); PG8_MMA(0, 1, At, B1); PG8_BAR; PG8_SCHED;
            PG8_LDA(At, 0, 1); PG8_STAGE(srdB, PG8_SB(0, 0), b2, voffB); PG8_STAGE(srdB, PG8_SB(0, 1), b2 + hstepB, voffB); PG8_STAGE(srdA, PG8_SA(0, 0), a2, voffA);
            PG8_WAIT_V(8); PG8_WAIT_L(0); PG8_BAR; PG8_MMA(1, 0, At, B0); PG8_MMA(1, 1, At, B1); PG8_BAR; PG8_SCHED;
            PG8_LDB(B0, 1, 0); PG8_LDB(B1, 1, 1); PG8_SCHED; PG8_LDA(At, 1, 0); PG8_STAGE(srdA, PG8_SA(0, 1), a2 + hstepA, voffA);
            PG8_WAIT_V(8); PG8_WAIT_L(0); PG8_BAR; PG8_MMA(0, 0, At, B0); PG8_MMA(0, 1, At, B1); PG8_BAR; PG8_SCHED;
            PG8_LDA(At, 1, 1); PG8_STAGE(srdB, PG8_SB(1, 0), b3, voffB); PG8_STAGE(srdB, PG8_SB(1, 1), b3 + hstepB, voffB); PG8_STAGE(srdA, PG8_SA(1, 0), a3, voffA);
            PG8_WAIT_V(8); PG8_WAIT_L(0); PG8_BAR; PG8_MMA(1, 0, At, B0); PG8_MMA(1, 1, At, B1); PG8_BAR; PG8_SCHED;
        }
        if constexpr (ALIGN_EPI) { if (wr == 0) PG8_BAR; }
        E(acc, cur, wr, wc, fr, fq);
        if (!has_next) break;
#pragma unroll
        for (int a = 0; a < 2; ++a)
#pragma unroll
            for (int b = 0; b < 2; ++b)
#pragma unroll
                for (int m = 0; m < 4; ++m)
#pragma unroll
                    for (int n = 0; n < 2; ++n) acc[a][b][m][n] = (f32x4){0.f, 0.f, 0.f, 0.f};
        cur = nxt; cA = nA; cB = nB; ++ui;
        if constexpr (ALIGN_EPI) { if (wr == 1) PG8_BAR; }
    }
    PG8_WAIT_V(0);
    if constexpr (!ALIGN_EPI) { if (wr == 0) PG8_BAR; }
    PG8_BAR;
#undef PG8_SA
#undef PG8_SB
#undef PG8_STAGE
#undef PG8_LDA
#undef PG8_LDB
#undef PG8_MMA
#undef PG8_BAR
#undef PG8_SCHED
#undef PG8_BASEA
#undef PG8_BASEB
}
}

using pg8::bf16_t; using pg8::f32x4; using pg8::u32x4; using pg8::Unit; using pg8::pack8;
typedef float f32x2 __attribute__((ext_vector_type(2)));
typedef unsigned u32x2 __attribute__((ext_vector_type(2)));
#define LASP __attribute__((address_space(3)))

__device__ __forceinline__ float bf2f(unsigned short h) { return __uint_as_float(((unsigned)h) << 16); }
__device__ __forceinline__ float sigmoidf_(float x) { return __builtin_amdgcn_rcpf(1.f + __builtin_amdgcn_exp2f(-1.4426950408889634f * x)); }
__device__ __forceinline__ float gelu_tanh(float y) { const float in = 0.7978845608028654f * (y + 0.044715f * y * y * y); return y * sigmoidf_(2.f * in); }
__device__ __forceinline__ int seq_pos(int row) { return row < MPROMPT ? (row & (LP - 1)) : (row - MPROMPT); }
__device__ __forceinline__ void rope8(f32x4& v0, f32x4& v1, const float* cs) {
    const f32x4 c0 = *(const f32x4*)cs, c1 = *(const f32x4*)(cs + 4);
    f32x4 o0, o1;
    o0[0] = v0[0] * c0[0] - v0[1] * c0[1]; o0[1] = v0[1] * c0[0] + v0[0] * c0[1];
    o0[2] = v0[2] * c0[2] - v0[3] * c0[3]; o0[3] = v0[3] * c0[2] + v0[2] * c0[3];
    o1[0] = v1[0] * c1[0] - v1[1] * c1[1]; o1[1] = v1[1] * c1[0] + v1[0] * c1[1];
    o1[2] = v1[2] * c1[2] - v1[3] * c1[3]; o1[3] = v1[3] * c1[2] + v1[2] * c1[3];
    v0 = o0; v1 = o1;
}

#define EPI_ARGS const f32x4 (&acc)[2][2][4][2], const Unit& u, int wr, int wc, int fr, int fq
#define EPI_ROW(ai, m) (u.pm * 256 + (ai) * 128 + wr * 64 + (m) * 16 + fr)
#define EPI_COL(bj) (u.pn * 256 + (bj) * 128 + wc * 32 + 8 * fq)

struct EpiInProj {
    static constexpr bool MID = false;
    bf16_t* CQ; bf16_t* CKV; bf16_t* UG; bf16_t* KR; float* rsq_q; float* rsq_kv; const float* rope;
    __device__ __forceinline__ void operator()(EPI_ARGS) const {
        const int pn = u.pn;
        if (pn <= 2) {
            bf16_t* base = pn < 2 ? CQ : CKV; const int ld = pn < 2 ? 512 : 256, colt = pn < 2 ? pn * 256 : 0; float* rs = pn < 2 ? rsq_q : rsq_kv;
#pragma unroll
            for (int ai = 0; ai < 2; ++ai)
#pragma unroll
                for (int m = 0; m < 4; ++m) { const int row = EPI_ROW(ai, m); float ss = 0.f;
#pragma unroll
                    for (int bj = 0; bj < 2; ++bj) { const f32x4 v0 = acc[ai][bj][m][0], v1 = acc[ai][bj][m][1];
                        ss += (v0[0] * v0[0] + v0[1] * v0[1]) + (v0[2] * v0[2] + v0[3] * v0[3]) + (v1[0] * v1[0] + v1[1] * v1[1]) + (v1[2] * v1[2] + v1[3] * v1[3]);
                        *(u32x4*)(base + (size_t)row * ld + colt + bj * 128 + wc * 32 + 8 * fq) = pack8(v0, v1); }
                    ss += __shfl_xor(ss, 16); ss += __shfl_xor(ss, 32);
                    if (fq == 0) atomicAdd(rs + row, ss); }
        } else if (pn <= 6) {
#pragma unroll
            for (int ai = 0; ai < 2; ++ai)
#pragma unroll
                for (int m = 0; m < 4; ++m) { const int row = EPI_ROW(ai, m), k = row >> 5, i = row & 31;
#pragma unroll
                    for (int bj = 0; bj < 2; ++bj) { const int nu = (pn - 3) * 256 + bj * 128 + wc * 32 + 8 * fq, gg = nu >> 4, c0 = nu & 15;
                        *(u32x4*)(UG + ((size_t)(gg * NCHUNK + k)) * 768 + i * 16 + c0) = pack8(acc[ai][bj][m][0], acc[ai][bj][m][1]); } }
        } else {
            if (wc < 2) { const int col = wc * 32 + 8 * fq;
#pragma unroll
                for (int ai = 0; ai < 2; ++ai)
#pragma unroll
                    for (int m = 0; m < 4; ++m) { const int row = EPI_ROW(ai, m); f32x4 v0 = acc[ai][0][m][0], v1 = acc[ai][0][m][1];
                        rope8(v0, v1, rope + (size_t)seq_pos(row) * 64 + col);
                        *(u32x4*)(KR + (size_t)row * 64 + col) = pack8(v0, v1); } }
        }
    }
};
struct EpiQ {
    static constexpr bool MID = false;
    bf16_t* Q; const float* rsq; const float* rope;
    __device__ __forceinline__ void operator()(EPI_ARGS) const {
#pragma unroll
        for (int ai = 0; ai < 2; ++ai)
#pragma unroll
            for (int m = 0; m < 4; ++m) { const int row = EPI_ROW(ai, m); const float rstd = __builtin_amdgcn_rsqf(rsq[row] * (1.f / 512.f) + RMS_EPS) * 0.10411754f  ; const int pos = seq_pos(row);
#pragma unroll
                for (int bj = 0; bj < 2; ++bj) { const int col0 = EPI_COL(bj), d = col0 % QKD; f32x4 v0 = acc[ai][bj][m][0] * rstd, v1 = acc[ai][bj][m][1] * rstd;
                    if (d >= 128) rope8(v0, v1, rope + (size_t)pos * 64 + (d - 128));
                    *(u32x4*)(Q + (size_t)row * 1536 + col0) = pack8(v0, v1); } }
    }
};
struct EpiScaleRow {
    static constexpr bool MID = false;
    bf16_t* O; int ld; const float* rsq; float inv_n;
    __device__ __forceinline__ void operator()(EPI_ARGS) const {
#pragma unroll
        for (int ai = 0; ai < 2; ++ai)
#pragma unroll
            for (int m = 0; m < 4; ++m) { const int row = EPI_ROW(ai, m); const float rstd = rsq ? __builtin_amdgcn_rsqf(rsq[row] * inv_n + RMS_EPS) : 1.f;
#pragma unroll
                for (int bj = 0; bj < 2; ++bj) *(u32x4*)(O + (size_t)row * ld + EPI_COL(bj)) = pack8(acc[ai][bj][m][0] * rstd, acc[ai][bj][m][1] * rstd);
                asm volatile("" ::: "memory"); }
    }
};
struct EpiOutProj {
    static constexpr bool MID = true;
    bf16_t* O; const float* rsqa; const float* rsqs;
    __device__ __forceinline__ void mid(f32x4 (&acc)[2][2][4][2], const Unit& u, int wr, int fr) const {
        int rb = u.pm * 256 + wr * 64 + fr; asm volatile("" : "+v"(rb));
#pragma unroll
        for (int ai = 0; ai < 2; ++ai)
#pragma unroll
            for (int m = 0; m < 4; ++m) { const int row = rb + ai * 128 + m * 16;
                const float ra = __builtin_amdgcn_rsqf(rsqa[row] * (1.f / 1024.f) + RMS_EPS), rs = __builtin_amdgcn_rsqf(rsqs[row] * (1.f / 1024.f) + RMS_EPS); const float k = ra * __builtin_amdgcn_rcpf(rs);
#pragma unroll
                for (int bj = 0; bj < 2; ++bj) { acc[ai][bj][m][0] *= k; acc[ai][bj][m][1] *= k; }
                if (m & 1) asm volatile("" ::: "memory"); }
    }
    __device__ __forceinline__ void operator()(EPI_ARGS) const {
#pragma unroll
        for (int ai = 0; ai < 2; ++ai)
#pragma unroll
            for (int m = 0; m < 4; ++m) { const int row = EPI_ROW(ai, m); const float rs = __builtin_amdgcn_rsqf(rsqs[row] * (1.f / 1024.f) + RMS_EPS);
#pragma unroll
                for (int bj = 0; bj < 2; ++bj) *(u32x4*)(O + (size_t)row * 2048 + EPI_COL(bj)) = pack8(acc[ai][bj][m][0] * rs, acc[ai][bj][m][1] * rs);
                asm volatile("" ::: "memory"); }
    }
};
struct EpiS {
    static constexpr bool MID = false;
    float* S;
    __device__ __forceinline__ void operator()(EPI_ARGS) const {
#pragma unroll
        for (int ai = 0; ai < 2; ++ai)
#pragma unroll
            for (int m = 0; m < 4; ++m) { const int row = EPI_ROW(ai, m);
#pragma unroll
                for (int bj = 0; bj < 2; ++bj) { float* p = S + ((size_t)u.g * NCHUNK + row) * 256 + EPI_COL(bj); *(f32x4*)p = acc[ai][bj][m][0]; *(f32x4*)(p + 4) = acc[ai][bj][m][1]; }
                asm volatile("" ::: "memory"); }
    }
};
struct EpiY {
    static constexpr bool MID = false;
    bf16_t* Y;
    __device__ __forceinline__ void operator()(EPI_ARGS) const {
#pragma unroll
        for (int ai = 0; ai < 2; ++ai)
#pragma unroll
            for (int m = 0; m < 4; ++m) { const int row = EPI_ROW(ai, m);
#pragma unroll
                for (int bj = 0; bj < 2; ++bj) { const int n = EPI_COL(bj), i = n >> 4, c0 = n & 15; f32x4 v0 = acc[ai][bj][m][0], v1 = acc[ai][bj][m][1];
#pragma unroll
                    for (int e = 0; e < 4; ++e) { v0[e] = gelu_tanh(v0[e]); v1[e] = gelu_tanh(v1[e]); }
                    *(u32x4*)(Y + (size_t)(row * TCH + i) * 1024 + u.g * 16 + c0) = pack8(v0, v1); } }
    }
};
struct EpiGlu {
    static constexpr bool MID = false;
    const bf16_t* Y; const float* bias; bf16_t* MIX; float* rsq;
    __device__ __forceinline__ void operator()(EPI_ARGS) const {
#pragma unroll
        for (int bj = 0; bj < 2; ++bj) { const int col0 = EPI_COL(bj); const f32x4 b0 = *(const f32x4*)(bias + col0), b1 = *(const f32x4*)(bias + col0 + 4);
#pragma unroll
            for (int ai = 0; ai < 2; ++ai)
#pragma unroll
                for (int m = 0; m < 4; ++m) { const int row = EPI_ROW(ai, m); const u32x4 yv = *(const u32x4*)(Y + (size_t)row * 1024 + col0);
                    f32x4 v0 = acc[ai][bj][m][0] + b0, v1 = acc[ai][bj][m][1] + b1;
                    v0[0] = __uint_as_float(yv.x << 16) * sigmoidf_(v0[0]); v0[1] = __uint_as_float(yv.x & 0xffff0000u) * sigmoidf_(v0[1]);
                    v0[2] = __uint_as_float(yv.y << 16) * sigmoidf_(v0[2]); v0[3] = __uint_as_float(yv.y & 0xffff0000u) * sigmoidf_(v0[3]);
                    v1[0] = __uint_as_float(yv.z << 16) * sigmoidf_(v1[0]); v1[1] = __uint_as_float(yv.z & 0xffff0000u) * sigmoidf_(v1[1]);
                    v1[2] = __uint_as_float(yv.w << 16) * sigmoidf_(v1[2]); v1[3] = __uint_as_float(yv.w & 0xffff0000u) * sigmoidf_(v1[3]);
                    *(u32x4*)(MIX + (size_t)row * 2048 + 1024 + col0) = pack8(v0, v1);
                    float ss = (v0[0] * v0[0] + v0[1] * v0[1]) + (v0[2] * v0[2] + v0[3] * v0[3]) + (v1[0] * v1[0] + v1[1] * v1[1]) + (v1[2] * v1[2] + v1[3] * v1[3]);
                    ss += __shfl_xor(ss, 16); ss += __shfl_xor(ss, 32);
                    if (fq == 0) atomicAdd(rsq + row, ss); } }
    }
};
struct EpiFfn {
    static constexpr bool MID = false;
    bf16_t* H; const float* rsq;
    __device__ __forceinline__ void operator()(EPI_ARGS) const {
        const int col0 = u.pn * 128 + wc * 32 + 8 * fq;
#pragma unroll
        for (int ai = 0; ai < 2; ++ai)
#pragma unroll
            for (int m = 0; m < 4; ++m) { const int row = EPI_ROW(ai, m); const float rs = __builtin_amdgcn_rsqf(rsq[row] * (1.f / DM) + RMS_EPS); f32x4 v0, v1;
#pragma unroll
                for (int e = 0; e < 4; ++e) { const float g0 = acc[ai][0][m][0][e] * rs, g1 = acc[ai][0][m][1][e] * rs;
                    v0[e] = g0 * sigmoidf_(g0) * (acc[ai][1][m][0][e] * rs); v1[e] = g1 * sigmoidf_(g1) * (acc[ai][1][m][1][e] * rs); }
                *(u32x4*)(H + (size_t)row * DFF + col0) = pack8(v0, v1);
                if (m & 1) asm volatile("" ::: "memory"); }
    }
};

namespace att {
using bf16x8 = __attribute__((ext_vector_type(8))) short;
using s16x4  = __attribute__((ext_vector_type(4))) short;
using f32x16 = __attribute__((ext_vector_type(16))) float;
constexpr int NW = 8, QBLK = 32, KVBLK = 64;
constexpr float SCALE = 0.07216878364870322f;
constexpr float THR = 8.f;
constexpr int LDQ = 1536, LDKV = 2112, LDO = 2048;
constexpr int SHM_V = KVBLK * 128 * 2, SHM_K = KVBLK * QKD * 2, SHM_ATTN = 2 * SHM_V + 3 * SHM_K + NW * 64 * 4 + NW * 4096;
#define KSWZ(row, colB) ((row) * 384 + ((colB) ^ ((((row) >> 1) & 7) << 4)))
#define SBAR() __builtin_amdgcn_sched_barrier(0)
__device__ __forceinline__ int crow(int r, int hi) { return (r & 3) + 8 * (r >> 2) + 4 * hi; }
typedef __bf16 bf16x2_t __attribute__((ext_vector_type(2)));
typedef float f32x2_t __attribute__((ext_vector_type(2)));
__device__ __forceinline__ unsigned cvtpk(float lo, float hi) { const f32x2_t v = {lo, hi}; return __builtin_bit_cast(unsigned, __builtin_convertvector(v, bf16x2_t)); }
__device__ __forceinline__ void partialSM(f32x16& p0, f32x16& p1, float& M, float& alpha) {
  float pmax = p0[0];
#pragma unroll
  for (int r = 1; r < 16; ++r) pmax = fmaxf(pmax, p0[r]);
#pragma unroll
  for (int r = 0; r < 16; ++r) pmax = fmaxf(pmax, p1[r]);
  { auto rr = __builtin_amdgcn_permlane32_swap(__float_as_uint(pmax), __float_as_uint(pmax), false, false);
    pmax = fmaxf(__uint_as_float(rr[0]), __uint_as_float(rr[1])); }
  const float mn = fmaxf(M, pmax);
  alpha = __builtin_amdgcn_exp2f(M - mn); M = mn;
#pragma unroll
  for (int r = 0; r < 16; ++r) { p0[r] -= mn; p1[r] -= mn; }
#pragma unroll
  for (int r = 0; r < 16; ++r) p0[r] = __builtin_amdgcn_exp2f(p0[r]);
}
__device__ __forceinline__ void finishSM(f32x16& p0, f32x16& p1, float alpha, float& l_reg, bf16x8& pa0, bf16x8& pa1, bf16x8& pa2, bf16x8& pa3) {
#pragma unroll
  for (int r = 0; r < 16; ++r) p1[r] = __builtin_amdgcn_exp2f(p1[r]);
  float ps = 0;
#pragma unroll
  for (int r = 0; r < 16; ++r) ps += p0[r];
#pragma unroll
  for (int r = 0; r < 16; ++r) ps += p1[r];
  { auto rr = __builtin_amdgcn_permlane32_swap(__float_as_uint(ps), __float_as_uint(ps), false, false);
    ps = __uint_as_float(rr[0]) + __uint_as_float(rr[1]); }
  l_reg = l_reg * alpha + ps;
#define PK4(P, BASE, OUT) do { unsigned a0 = cvtpk(P[BASE + 0], P[BASE + 1]), a1 = cvtpk(P[BASE + 2], P[BASE + 3]);   \
    unsigned b0 = cvtpk(P[BASE + 4], P[BASE + 5]), b1 = cvtpk(P[BASE + 6], P[BASE + 7]);                              \
    auto r0 = __builtin_amdgcn_permlane32_swap(a0, b0, false, false); auto r1 = __builtin_amdgcn_permlane32_swap(a1, b1, false, false); \
    u32x4 w = {r0[0], r1[0], r0[1], r1[1]}; OUT = *reinterpret_cast<bf16x8*>(&w); } while (0)
  PK4(p0, 0, pa0); PK4(p0, 8, pa1); PK4(p1, 0, pa2); PK4(p1, 8, pa3);
#undef PK4
}
__device__ __forceinline__ void qkt(f32x16& p0, f32x16& p1, const char* Ks, const bf16x8* qr, const char* qlds, const int* kb) {
  p0 = f32x16{}; p1 = f32x16{};
#pragma unroll
  for (int d0 = 0; d0 < 12; ++d0) { const int off = kb[d0 & 3] + (d0 >> 2) * 128;
    bf16x8 b0 = *reinterpret_cast<const bf16x8*>(Ks + off);
    bf16x8 b1 = *reinterpret_cast<const bf16x8*>(Ks + off + 32 * 384);
    bf16x8 q; if (d0 < 8) q = qr[d0]; else q = *reinterpret_cast<const bf16x8*>(qlds + (d0 - 8) * 1024);
    p0 = __builtin_amdgcn_mfma_f32_32x32x16_bf16(b0, q, p0, 0, 0, 0);
    p1 = __builtin_amdgcn_mfma_f32_32x32x16_bf16(b1, q, p1, 0, 0, 0); }
}
__device__ __forceinline__ int v_st(int k, int c) { const int kk = (k & ~0xC) | ((k & 4) << 1) | ((k & 8) >> 1); return ((kk >> 3) * 4 + (c >> 5)) * 512 + ((kk & 7) * 32 + (c & 31)) * 2; }
__device__ __forceinline__ int v_rd_base(int lane) { return ((lane & 3) << 3) | (((lane >> 2) & 3) << 6) | (((lane >> 4) & 1) << 5) | (((lane >> 5) & 1) << 8); }
constexpr int v_rd_off(int d0, int ks, int half) { return d0 * 512 + ks * 4096 + half * 2048; }
typedef __attribute__((address_space(3))) s16x4 lds_s16x4;
template <int OFF> __device__ __forceinline__ s16x4 tr_read(const __attribute__((address_space(3))) char* vb) { return __builtin_amdgcn_ds_read_tr16_b64_v4i16((lds_s16x4*)(vb + OFF)); }
template <int D0> __device__ __forceinline__ void pv_one(f32x16& od, const __attribute__((address_space(3))) char* vb, bf16x8 pa0, bf16x8 pa1, bf16x8 pa2, bf16x8 pa3) {
  const s16x4 l0 = tr_read<v_rd_off(D0, 0, 0)>(vb), h0 = tr_read<v_rd_off(D0, 0, 1)>(vb), l1 = tr_read<v_rd_off(D0, 1, 0)>(vb), h1 = tr_read<v_rd_off(D0, 1, 1)>(vb);
  const s16x4 l2 = tr_read<v_rd_off(D0, 2, 0)>(vb), h2 = tr_read<v_rd_off(D0, 2, 1)>(vb), l3 = tr_read<v_rd_off(D0, 3, 0)>(vb), h3 = tr_read<v_rd_off(D0, 3, 1)>(vb);
#define PK(L, H) (bf16x8){L[0], L[1], L[2], L[3], H[0], H[1], H[2], H[3]}
  od = __builtin_amdgcn_mfma_f32_32x32x16_bf16(pa0, PK(l0, h0), od, 0, 0, 0);
  od = __builtin_amdgcn_mfma_f32_32x32x16_bf16(pa1, PK(l1, h1), od, 0, 0, 0);
  od = __builtin_amdgcn_mfma_f32_32x32x16_bf16(pa2, PK(l2, h2), od, 0, 0, 0);
  od = __builtin_amdgcn_mfma_f32_32x32x16_bf16(pa3, PK(l3, h3), od, 0, 0, 0);
#undef PK
}
__device__ __forceinline__ void pv_d0(f32x16* o, const __attribute__((address_space(3))) char* vb, bf16x8 pa0, bf16x8 pa1, bf16x8 pa2, bf16x8 pa3) {
  pv_one<0>(o[0], vb, pa0, pa1, pa2, pa3); pv_one<1>(o[1], vb, pa0, pa1, pa2, pa3); pv_one<2>(o[2], vb, pa0, pa1, pa2, pa3); pv_one<3>(o[3], vb, pa0, pa1, pa2, pa3);
}
struct SMState { float ps, pmax; };
template <int I> __device__ __forceinline__ void fs_chunk(f32x16& p0, f32x16& p1, float alpha, float& l_reg, SMState& st, bf16x8& pa0, bf16x8& pa1, bf16x8& pa2, bf16x8& pa3) {
#define PK4(P, BASE, OUT) do { unsigned a0 = cvtpk(P[BASE + 0], P[BASE + 1]), a1 = cvtpk(P[BASE + 2], P[BASE + 3]);   \
    unsigned b0 = cvtpk(P[BASE + 4], P[BASE + 5]), b1 = cvtpk(P[BASE + 6], P[BASE + 7]);                              \
    auto r0 = __builtin_amdgcn_permlane32_swap(a0, b0, false, false); auto r1 = __builtin_amdgcn_permlane32_swap(a1, b1, false, false); \
    u32x4 w = {r0[0], r1[0], r0[1], r1[1]}; OUT = *reinterpret_cast<bf16x8*>(&w); } while (0)
  if constexpr (I < 4) {
#pragma unroll
    for (int r = 4 * I; r < 4 * I + 4; ++r) p1[r] = __builtin_amdgcn_exp2f(p1[r]);
    if constexpr (I == 0) st.ps = 0.f;
  } else if constexpr (I < 8) { constexpr int j = 4 * (I - 4);
#pragma unroll
    for (int r = j; r < j + 4; ++r) st.ps += p0[r];
#pragma unroll
    for (int r = j; r < j + 4; ++r) st.ps += p1[r];
  } else if constexpr (I == 8) {
    const float ps_ = st.ps;
    auto rr = __builtin_amdgcn_permlane32_swap(__float_as_uint(ps_), __float_as_uint(ps_), false, false);
    l_reg = l_reg * alpha + (__uint_as_float(rr[0]) + __uint_as_float(rr[1]));
    PK4(p0, 0, pa0);
  } else if constexpr (I == 9) { PK4(p0, 8, pa1); }
  else if constexpr (I == 10) { PK4(p1, 0, pa2); }
  else { PK4(p1, 8, pa3); }
#undef PK4
}
constexpr float THR2 = THR * 1.4426950408889634f;
template <int I> __device__ __forceinline__ void ps_chunk(f32x16& p0, f32x16& p1, float& M, float& alpha, SMState& st) {
  if constexpr (I == 0) { float m = p0[0];
#pragma unroll
    for (int r = 1; r < 16; ++r) m = fmaxf(m, p0[r]);
    st.pmax = m;
  } else if constexpr (I == 1) { float m = st.pmax;
#pragma unroll
    for (int r = 0; r < 16; ++r) m = fmaxf(m, p1[r]);
    auto rr = __builtin_amdgcn_permlane32_swap(__float_as_uint(m), __float_as_uint(m), false, false);
    st.pmax = fmaxf(__uint_as_float(rr[0]), __uint_as_float(rr[1]));
  } else if constexpr (I == 2) {
    alpha = 1.f;
    if (__builtin_expect(!__all(st.pmax <= THR2), 0)) { const float d = fmaxf(st.pmax, 0.f); M += d; alpha = __builtin_amdgcn_exp2f(-d);
#pragma unroll
      for (int r = 0; r < 16; ++r) { p0[r] -= d; p1[r] -= d; } }
#pragma unroll
    for (int r = 0; r < 2; ++r) p0[r] = __builtin_amdgcn_exp2f(p0[r]);
  } else if constexpr (I < 7) { constexpr int lo = 2 + 3 * (I - 3), hi_ = lo + 3;
#pragma unroll
    for (int r = lo; r < hi_; ++r) p0[r] = __builtin_amdgcn_exp2f(p0[r]);
  } else {
#pragma unroll
    for (int r = 14; r < 16; ++r) p0[r] = __builtin_amdgcn_exp2f(p0[r]);
  }
  if constexpr (I >= 2) asm volatile("" : "+v"(p0), "+v"(p1));
}
__device__ __forceinline__ void partialSM0(f32x16& p0, f32x16& p1, float& M) {
  float pmax = p0[0];
#pragma unroll
  for (int r = 1; r < 16; ++r) pmax = fmaxf(pmax, p0[r]);
#pragma unroll
  for (int r = 0; r < 16; ++r) pmax = fmaxf(pmax, p1[r]);
  { auto rr = __builtin_amdgcn_permlane32_swap(__float_as_uint(pmax), __float_as_uint(pmax), false, false);
    pmax = fmaxf(__uint_as_float(rr[0]), __uint_as_float(rr[1])); }
  M = pmax;
#pragma unroll
  for (int r = 0; r < 16; ++r) { p0[r] -= pmax; p1[r] -= pmax; }
#pragma unroll
  for (int r = 0; r < 16; ++r) p0[r] = __builtin_amdgcn_exp2f(p0[r]);
}
template <int D0> __device__ __forceinline__ void kq_load(bf16x8& b0, bf16x8& b1, bf16x8& q, const char* Ks, const bf16x8* qr, const char* qlds, const int* kb) {
  const int off = kb[D0 & 3] + (D0 >> 2) * 128;
  b0 = *reinterpret_cast<const bf16x8*>(Ks + off); b1 = *reinterpret_cast<const bf16x8*>(Ks + off + 32 * 384);
  if constexpr (D0 < 8) q = qr[D0]; else q = *reinterpret_cast<const bf16x8*>(qlds + (D0 - 8) * 1024);
}
struct DmaCtx { unsigned gk, gv; unsigned koff[3], voff[2]; char* kd; char* vd; int wid; __amdgpu_buffer_rsrc_t srd; };
typedef __attribute__((address_space(3))) unsigned lds_u32_t;
template <int P> __device__ __forceinline__ void dma_piece(const DmaCtx& c) {
  if constexpr (P < 3) __builtin_amdgcn_raw_ptr_buffer_load_lds(c.srd, (lds_u32_t*)(c.kd + (c.wid + 8 * P) * 1024), 16, c.koff[P], c.gk, 0, 0);
  else __builtin_amdgcn_raw_ptr_buffer_load_lds(c.srd, (lds_u32_t*)(c.vd + (c.wid + 8 * (P - 3)) * 1024), 16, c.voff[P - 3], c.gv, 0, 0);
}
template <int D0> __device__ __forceinline__ void h1_stage(f32x16& pc0, f32x16& pc1, f32x16& pp0, f32x16& pp1, float alP, float& l_reg, SMState& st, bf16x8& pa0, bf16x8& pa1, bf16x8& pa2, bf16x8& pa3,
                                                           bf16x8 b0, bf16x8 b1, bf16x8 q, const char* Ks, const bf16x8* qr, const char* qlds, const int* kb, const DmaCtx& dc, const f32x16& negM) {
  bf16x8 n0, n1, nq;
  if constexpr (D0 < 11) kq_load<D0 + 1>(n0, n1, nq, Ks, qr, qlds, kb);
  if constexpr (D0 == 0) {
    pc0 = __builtin_amdgcn_mfma_f32_32x32x16_bf16(b0, q, negM, 0, 0, 0);
    pc1 = __builtin_amdgcn_mfma_f32_32x32x16_bf16(b1, q, negM, 0, 0, 0);
  } else {
    pc0 = __builtin_amdgcn_mfma_f32_32x32x16_bf16(b0, q, pc0, 0, 0, 0);
    pc1 = __builtin_amdgcn_mfma_f32_32x32x16_bf16(b1, q, pc1, 0, 0, 0);
  }
  if constexpr (D0 >= 1 && D0 <= 5) dma_piece<D0 - 1>(dc);
  SBAR(); fs_chunk<D0>(pp0, pp1, alP, l_reg, st, pa0, pa1, pa2, pa3); SBAR();
  if constexpr (D0 < 11) h1_stage<D0 + 1>(pc0, pc1, pp0, pp1, alP, l_reg, st, pa0, pa1, pa2, pa3, n0, n1, nq, Ks, qr, qlds, kb, dc, negM);
}
typedef __attribute__((address_space(3))) s16x4 lds_s16x4b;
template <int G> __device__ __forceinline__ void v_load(s16x4& la, s16x4& ha, s16x4& lb, s16x4& hb, const __attribute__((address_space(3))) char* vb) {
  constexpr int ks = G >> 1, d0 = (G & 1) * 2;
  la = __builtin_amdgcn_ds_read_tr16_b64_v4i16((lds_s16x4b*)(vb + v_rd_off(d0, ks, 0))); ha = __builtin_amdgcn_ds_read_tr16_b64_v4i16((lds_s16x4b*)(vb + v_rd_off(d0, ks, 1)));
  lb = __builtin_amdgcn_ds_read_tr16_b64_v4i16((lds_s16x4b*)(vb + v_rd_off(d0 + 1, ks, 0))); hb = __builtin_amdgcn_ds_read_tr16_b64_v4i16((lds_s16x4b*)(vb + v_rd_off(d0 + 1, ks, 1)));
}
template <int G> __device__ __forceinline__ void h2_stage(f32x16* o, f32x16& pc0, f32x16& pc1, float& m_reg, float& alC, SMState& st, bf16x8 pa0, bf16x8 pa1, bf16x8 pa2, bf16x8 pa3,
                                                          s16x4 la, s16x4 ha, s16x4 lb, s16x4 hb, const __attribute__((address_space(3))) char* vb) {
  constexpr int ks = G >> 1, d0 = (G & 1) * 2;
  s16x4 nla, nha, nlb, nhb;
  if constexpr (G < 7) v_load<G + 1>(nla, nha, nlb, nhb, vb);
  const bf16x8 pa = ks == 0 ? pa0 : ks == 1 ? pa1 : ks == 2 ? pa2 : pa3;
#define PK(L, H) (bf16x8){L[0], L[1], L[2], L[3], H[0], H[1], H[2], H[3]}
  o[d0] = __builtin_amdgcn_mfma_f32_32x32x16_bf16(pa, PK(la, ha), o[d0], 0, 0, 0);
  o[d0 + 1] = __builtin_amdgcn_mfma_f32_32x32x16_bf16(pa, PK(lb, hb), o[d0 + 1], 0, 0, 0);
#undef PK
  SBAR(); ps_chunk<G>(pc0, pc1, m_reg, alC, st); SBAR();
  if constexpr (G < 7) h2_stage<G + 1>(o, pc0, pc1, m_reg, alC, st, pa0, pa1, pa2, pa3, nla, nha, nlb, nhb, vb);
}
__device__ __forceinline__ void attn_body(const bf16_t* __restrict__ Qb, const bf16_t* __restrict__ KVb, int hcol, bf16_t* __restrict__ Ob, float* __restrict__ rsqa, int seq, char* lds) {
  int tid_ = threadIdx.x; asm volatile("" : "+v"(tid_));
  const int tid = tid_, wid = __builtin_amdgcn_readfirstlane(tid >> 6), lane = tid & 63, r32 = lane & 31, hi = lane >> 5;
  char* V_lds = lds; char* K_lds = lds + 2 * SHM_V;
  float* ws = (float*)(lds + 2 * SHM_V + 3 * SHM_K) + wid * 64; float* li_l = ws; float* al_l = ws + 32;
  float m_reg = -1e30f, l_reg = 0; f32x16 o[4] = {}; bf16x8 qr[8];
  char* qlds = lds + 2 * SHM_V + 3 * SHM_K + NW * 64 * 4 + wid * 4096 + lane * 16;
  int kb[4];
#pragma unroll
  for (int dl = 0; dl < 4; ++dl) kb[dl] = r32 * 384 + ((dl * 32 + hi * 16) ^ (((r32 >> 1) & 7) << 4));
  const bf16_t* Qw = Qb + (long)(wid * QBLK + r32) * LDQ + hi * 8;
#pragma unroll
  for (int d0 = 0; d0 < 8; ++d0) qr[d0] = *reinterpret_cast<const bf16x8*>(Qw + d0 * 16);
#pragma unroll
  for (int d0 = 8; d0 < 12; ++d0) *reinterpret_cast<bf16x8*>(qlds + (d0 - 8) * 1024) = *reinterpret_cast<const bf16x8*>(Qw + d0 * 16);
  DmaCtx dc; dc.wid = wid; dc.srd = __builtin_amdgcn_make_buffer_rsrc((void*)KVb, (short)0, 0x7fffffff, 0x00020000);
#pragma unroll
  for (int i = 0; i < 3; ++i) { const int b = (wid + 8 * i) * 1024 + lane * 16, row = b / 384, x = b % 384, blk = x >> 7, ch = ((x & 127) >> 4) ^ ((row >> 1) & 7), col = blk * 64 + ch * 8;
    dc.koff[i] = (unsigned)(row * LDKV + (col < 128 ? hcol + col : 2048 + (col - 128))) * 2u; }
#pragma unroll
  for (int i = 0; i < 2; ++i) { const int b = (wid + 8 * i) * 1024 + lane * 16, st_ = b >> 9, kk = (st_ >> 2) * 8 + ((b & 511) >> 6), c = (st_ & 3) * 32 + ((b & 63) >> 1);
    const int k = (kk & ~0xC) | ((kk & 4) << 1) | ((kk & 8) >> 1);
    dc.voff[i] = (unsigned)(k * LDKV + hcol + 128 + c) * 2u; }
  const __attribute__((address_space(3))) char* vb0 = (const __attribute__((address_space(3))) char*)V_lds + v_rd_base(lane);
  constexpr size_t TILEB = (size_t)KVBLK * LDKV * 2;
#define DMAK(t, s) do { dc.gk = (unsigned)((size_t)(t) * TILEB); dc.kd = K_lds + (s) * SHM_K; dma_piece<0>(dc); dma_piece<1>(dc); dma_piece<2>(dc); } while (0)
#define DMAV(t, s) do { dc.gv = (unsigned)((size_t)(t) * TILEB); dc.vd = V_lds + (s) * SHM_V; dma_piece<3>(dc); dma_piece<4>(dc); } while (0)
#define BAR() do { asm volatile("s_waitcnt lgkmcnt(0)" ::: "memory"); __builtin_amdgcn_s_barrier(); asm volatile("" ::: "memory"); } while (0)
#define NEXT3(s) ((s) == 2 ? 0 : (s) + 1)
#define RESC(a) do { if (__any((a) < 1.f)) { if (hi == 0) al_l[r32] = (a); asm volatile("s_waitcnt lgkmcnt(0)" ::: "memory"); \
    _Pragma("unroll") for (int d = 0; d < 4; ++d) _Pragma("unroll") for (int r = 0; r < 16; ++r) o[d][r] *= al_l[crow(r, hi)]; \
    _Pragma("unroll") for (int r = 0; r < 16; ++r) negM[r] = -m_reg; } } while (0)
#define STEP(PC0, PC1, alC, PP0, PP1, alP, t, sc_, VB) do { \
    SBAR(); \
    dc.gk = (unsigned)((size_t)((t) + 1) * TILEB); dc.kd = K_lds + NEXT3(sc_) * SHM_K; dc.gv = (unsigned)((size_t)(t) * TILEB); dc.vd = V_lds + (1 - (VB)) * SHM_V; \
    { bf16x8 b0_, b1_, q_; const char* Ks_ = K_lds + (sc_) * SHM_K; kq_load<0>(b0_, b1_, q_, Ks_, qr, qlds, kb); \
      h1_stage<0>(PC0, PC1, PP0, PP1, alP, l_reg, st, pa0, pa1, pa2, pa3, b0_, b1_, q_, Ks_, qr, qlds, kb, dc, negM); } \
    { s16x4 la_, ha_, lb_, hb_; const __attribute__((address_space(3))) char* vb_ = vb0 + (VB) * SHM_V; v_load<0>(la_, ha_, lb_, hb_, vb_); \
      h2_stage<0>(o, PC0, PC1, m_reg, alC, st, pa0, pa1, pa2, pa3, la_, ha_, lb_, hb_, vb_); } \
    SBAR(); \
    asm volatile("s_waitcnt vmcnt(0)" ::: "memory");     \
    RESC(alC); BAR();                                     \
    } while (0)
  f32x16 pA0, pA1, pB0, pB1; float alA, alB; bf16x8 pa0, pa1, pa2, pa3; SMState st; const int NT = seq / KVBLK;
  DMAK(0, 0); DMAV(0, 0); DMAK(1, 1);
  asm volatile("s_waitcnt vmcnt(3)" ::: "memory"); BAR();
  qkt(pA0, pA1, K_lds, qr, qlds, kb); partialSM0(pA0, pA1, m_reg); alA = 1.f;
  f32x16 negM;
#pragma unroll
  for (int r_ = 0; r_ < 16; ++r_) negM[r_] = -m_reg;
  asm volatile("s_waitcnt vmcnt(0)" ::: "memory"); BAR();
  int sc = 1;
  for (int j = 1; j + 1 < NT; j += 2) {
    STEP(pB0, pB1, alB, pA0, pA1, alA, j, sc, 0);
    sc = NEXT3(sc);
    STEP(pA0, pA1, alA, pB0, pB1, alB, j + 1, sc, 1);
    sc = NEXT3(sc);
  }
  DMAV(NT - 1, 1);
  SBAR(); qkt(pB0, pB1, K_lds + sc * SHM_K, qr, qlds, kb);
  finishSM(pA0, pA1, alA, l_reg, pa0, pa1, pa2, pa3);
  pv_d0(o, vb0, pa0, pa1, pa2, pa3); partialSM(pB0, pB1, m_reg, alB);
  SBAR(); asm volatile("s_waitcnt vmcnt(0)" ::: "memory"); RESC(alB); BAR();
  finishSM(pB0, pB1, alB, l_reg, pa0, pa1, pa2, pa3);
  pv_d0(o, vb0 + SHM_V, pa0, pa1, pa2, pa3);
  if (hi == 0) li_l[r32] = l_reg; asm volatile("s_waitcnt lgkmcnt(0)" ::: "memory");
  float rli[16];
#pragma unroll
  for (int r = 0; r < 16; ++r) rli[r] = __builtin_amdgcn_rcpf(li_l[crow(r, hi)]);
  bf16_t* Ow = Ob + (long)(wid * QBLK) * LDO;
#pragma unroll
  for (int r = 0; r < 16; ++r) { int orow = crow(r, hi); float sq = 0.f;
#pragma unroll
    for (int d0 = 0; d0 < 4; ++d0) { const float v = o[d0][r] * rli[r]; sq += v * v; Ow[(long)orow * LDO + d0 * 32 + r32] = (bf16_t)(cvtpk(v, 0.f) & 0xffffu); }
    sq += __shfl_xor(sq, 1); sq += __shfl_xor(sq, 2); sq += __shfl_xor(sq, 4); sq += __shfl_xor(sq, 8); sq += __shfl_xor(sq, 16);
    if (r32 == 0) atomicAdd(rsqa + wid * QBLK + orow, sq); }
#undef DMAK
#undef DMAV
#undef BAR
#undef NEXT3
#undef RESC
#undef STEP
}
}

constexpr size_t MiB = 1u << 20;
constexpr size_t WS_RSQQ = 0, WS_RSQKV = 128 * 1024, WS_BAR = 256 * 1024, BAR_BYTES = 16 * 1024, WS_RSQA = 384 * 1024, WS_RSQS = 512 * 1024, WS_RSQX = 640 * 1024;
constexpr size_t WS_ROPE = 1 * MiB, WS_KT = 5 * MiB;
constexpr size_t WS_WGU = 10 * MiB, WS_WDOWN = 54 * MiB, WS_WIN = 76 * MiB, WS_WQB = 84 * MiB, WS_WKVB = 86 * MiB, WS_WGLU = 87 * MiB, WS_WOUT = 89 * MiB;
constexpr size_t WS_KW = 97 * MiB, WS_WST = 145 * MiB;
constexpr size_t WS_XN = 161 * MiB, WS_KV = 161 * MiB, WS_MB = 161 * MiB;
constexpr size_t WS_CQ = 260 * MiB, WS_CKV = 284 * MiB, WS_UG = 299 * MiB, WS_MIX = 260 * MiB;
constexpr size_t WS_Q = 371 * MiB, WS_SBUF = 443 * MiB, WS_Y = 443 * MiB, WS_KR = 491 * MiB;
constexpr size_t WS_H = 416 * MiB, WS_F = 416 * MiB, WS_HMID = 76 * MiB, WS_END = 512 * MiB;

constexpr int LDS_BYTES = 147456;
#ifndef PH_MASK
#define PH_MASK 0xFFF
#endif
#ifndef ATT_REP
#define ATT_REP 1
#endif
#ifndef FFN_REP
#define FFN_REP 1
#endif
#define PH_ON(k) if constexpr (((PH_MASK) >> (k)) & 1)

struct Params {
    const float* in[27]; float* out; unsigned char* ws;
};

__device__ __forceinline__ float wave_sum(float v) {
#pragma unroll
    for (int o = 1; o < 64; o <<= 1) v += __shfl_xor(v, o);
    return v;
}
typedef __bf16 bf16x2_h __attribute__((ext_vector_type(2)));
typedef float f32x2_h __attribute__((ext_vector_type(2)));
__device__ __forceinline__ unsigned pk2(float lo, float hi) { const f32x2_h v = {lo, hi}; return __builtin_bit_cast(unsigned, __builtin_convertvector(v, bf16x2_h)); }
__device__ __forceinline__ unsigned f2bf(float f) { return pk2(f, 0.f) & 0xffffu; }
__device__ __forceinline__ int il64(int r) { return r < 32 ? 2 * r : 2 * (r - 32) + 1; }
__device__ __forceinline__ int map_row(int mode, int n) {
    switch (mode) {
        case 1: return n < 768 ? n : (n < 832 ? 1792 + il64(n - 768) : 768 + (n - 832));
        case 2: { const int h = n / 192, d = n % 192; return d < 128 ? n : h * 192 + 128 + il64(d - 128); }
        case 3: return (n >> 7) * 256 + (n & 127);
        case 4: return (n >> 7) * 256 + 128 + (n & 127);
        default: return n;
    }
}
__device__ __forceinline__ void transpose_item(const float* W, int K, int N, bf16_t* WT, int mode, const float* gain, LASP float* scr, int item, int lane) {
    const int nblk = N / 32, kb = item / nblk, nb = item % nblk, k0 = 64 * kb, n0 = 32 * nb;
    float tv[32];
#pragma unroll
    for (int i = 0; i < 32; ++i) tv[i] = W[(size_t)(k0 + 2 * i + (lane >> 5)) * N + n0 + (lane & 31)];
    if (gain) {
#pragma unroll
        for (int i = 0; i < 32; ++i) tv[i] *= gain[k0 + 2 * i + (lane >> 5)]; }
#pragma unroll
    for (int i = 0; i < 32; ++i) scr[(2 * i + (lane >> 5)) * 33 + (lane & 31)] = tv[i];
    asm volatile("s_waitcnt lgkmcnt(0)" ::: "memory");
    const int c = lane & 7;
#pragma unroll
    for (int j = 0; j < 4; ++j) { const int n = (lane >> 3) + 8 * j; const LASP float* s = scr + (8 * c) * 33 + n;
        u32x4 o; o.x = pk2(s[0 * 33], s[1 * 33]); o.y = pk2(s[2 * 33], s[3 * 33]); o.z = pk2(s[4 * 33], s[5 * 33]); o.w = pk2(s[6 * 33], s[7 * 33]);
        *(u32x4*)(WT + (size_t)map_row(mode, n0 + n) * K + k0 + 8 * c) = o; }
    asm volatile("s_waitcnt lgkmcnt(0)" ::: "memory");
}
__device__ __forceinline__ const float* xrow_ptr(const Params& p, int row) { return row < MPROMPT ? p.in[0] + (size_t)row * DM : p.in[1] + (size_t)(row - MPROMPT) * DM; }

struct cf { float re, im; };
__device__ __forceinline__ cf cmul(cf a, cf b) { return cf{a.re * b.re - a.im * b.im, a.re * b.im + a.im * b.re}; }
__device__ __forceinline__ cf lam_pow(float a, float brev, float e) {
    const float mag = __expf(e * a); float rev = e * brev; rev -= __builtin_rintf(rev);
    return cf{mag * __builtin_amdgcn_cosf(rev), mag * __builtin_amdgcn_sinf(rev)};
}
__device__ __forceinline__ cf zoh_coef(float lre, float lim, float dt) {
    const float a = lre * dt, b = lim * dt, brev = b * 0.15915494309189535f;
    const float em1 = expm1f(a), ea = em1 + 1.f, cb = __builtin_amdgcn_cosf(brev), sb = __builtin_amdgcn_sinf(brev), sh = __builtin_amdgcn_sinf(0.5f * brev);
    const float nr = em1 * cb - 2.f * sh * sh, ni = ea * sb;
    const float den = 1.f / (lre * lre + lim * lim);
    return cf{(nr * lre + ni * lim) * den, (ni * lre - nr * lim) * den};
}

#define XB_TMO      128
#define XB_XCNT(j)  (256  + 64 * (j))
#define XB_XSUB(j)  (1280 + 64 * (j))
#define XB_XGEN(j)  (2304 + 64 * (j))
#define XB_TOP      3328
#define XB_TOPGEN   3392
#define XCD_BAR_WORDS 3456
#define XB_SPIN_CAP (1u << 18)

__device__ __forceinline__ unsigned xb_ld(unsigned* p)              { return __hip_atomic_load(p, __ATOMIC_RELAXED, __HIP_MEMORY_SCOPE_AGENT); }
__device__ __forceinline__ unsigned xb_add(unsigned* p, unsigned v) { return __hip_atomic_fetch_add(p, v, __ATOMIC_RELAXED, __HIP_MEMORY_SCOPE_AGENT); }
__device__ __forceinline__ unsigned xb_xcc_id() { return (unsigned)__builtin_amdgcn_s_getreg((3 << 11) | 20) & 0xFu; }
#define XB_SPIN(cond, bar) do { unsigned _sp = 0; while (cond) { __builtin_amdgcn_s_sleep(1); \
    if ((++_sp & 255u) == 0u) { if (xb_ld(&(bar)[XB_TMO])) break; if (_sp > XB_SPIN_CAP) { atomicAdd(&(bar)[XB_TMO], 1u); break; } } } } while (0)

struct XcdBarrier {
    unsigned* bar; unsigned x;
    volatile LASP unsigned* st;
};

__device__ __forceinline__ XcdBarrier xcd_barrier_post(unsigned* bar, volatile LASP unsigned* st) {
    XcdBarrier b; b.bar = bar; b.x = xb_xcc_id(); b.st = st;
    if (threadIdx.x == 0) (void)xb_add(&bar[XB_XCNT(b.x)], 1u);
    return b;
}
__device__ __forceinline__ void xcd_barrier_complete(unsigned* bar, unsigned x, unsigned& nloc, unsigned& nx) {
    const unsigned G = gridDim.x * gridDim.y * gridDim.z;
    unsigned sum, cnt, mine, sp = 0u;
    for (;;) {
        sum = 0u; cnt = 0u; mine = 0u;
#pragma unroll
        for (unsigned j = 0; j < 16; ++j) { const unsigned c = xb_ld(&bar[XB_XCNT(j)]); sum += c; cnt += (c > 0u) ? 1u : 0u; mine = (j == x) ? c : mine; }
        if (sum == G) break;
        __builtin_amdgcn_s_sleep(1);
        if ((++sp & 255u) == 0u) { if (xb_ld(&bar[XB_TMO])) break; if (sp > XB_SPIN_CAP) { atomicAdd(&bar[XB_TMO], 1u); break; } }
    }
    nloc = mine > 0u ? mine : 1u; nx = cnt > 0u ? cnt : 1u;
}

__device__ __forceinline__ void xcd_barrier(const XcdBarrier& b) {
    asm volatile("s_waitcnt vmcnt(0)" ::: "memory");
    __syncthreads();
    if (threadIdx.x == 0) {
        unsigned* bar = b.bar;
        __builtin_amdgcn_s_waitcnt(0);
        unsigned nloc = b.st[0], nx = b.st[1];
        if (nloc == 0u) { xcd_barrier_complete(bar, b.x, nloc, nx); b.st[0] = nloc; b.st[1] = nx; }
        const unsigned old = xb_add(&bar[XB_XSUB(b.x)], 1u);
        const unsigned gen = old / nloc;
        if (old + 1u == (gen + 1u) * nloc) {
            __builtin_amdgcn_fence(__ATOMIC_RELEASE, "agent");
            asm volatile("s_waitcnt vmcnt(0)" ::: "memory");
            const unsigned og = xb_add(&bar[XB_TOP], 1u);
            const unsigned tg = og / nx;
            if (og + 1u == (tg + 1u) * nx) xb_add(&bar[XB_TOPGEN], 1u);
            else XB_SPIN(xb_ld(&bar[XB_TOPGEN]) == tg, bar);
            __builtin_amdgcn_fence(__ATOMIC_ACQUIRE, "agent");
            xb_add(&bar[XB_XGEN(b.x)], 1u);
            asm volatile("s_waitcnt vmcnt(0)" ::: "memory");
        } else {
            XB_SPIN(xb_ld(&bar[XB_XGEN(b.x)]) == gen, bar);
            __builtin_amdgcn_fence(__ATOMIC_ACQUIRE, "agent");
            asm volatile("s_waitcnt vmcnt(0)" ::: "memory");
        }
    }
    __syncthreads();
}


__device__ __forceinline__ void ffn_weight_items(const Params& p, unsigned char* ws, LASP unsigned char* ldsl, int lo, int hi, int bid, int wave, int lane) {
    constexpr int I_G = (DM / 64) * (DFF / 32);
    LASP float* scr = (LASP float*)(ldsl + wave * 16384);
    for (int it = lo + (bid - 128) * 8 + wave; it < hi; it += 128 * 8) {
        int r = it;
        if (r < I_G) { transpose_item(p.in[23], DM, DFF, (bf16_t*)(ws + WS_WGU), 3, p.in[22], scr, r, lane); continue; } r -= I_G;
        if (r < I_G) { transpose_item(p.in[24], DM, DFF, (bf16_t*)(ws + WS_WGU), 4, p.in[22], scr, r, lane); continue; } r -= I_G;
        transpose_item(p.in[25], DFF, DM, (bf16_t*)(ws + WS_WDOWN), 0, nullptr, scr, r, lane);
    }
}
template <int SEG>
__device__ __forceinline__ void scan_item(const Params& p, unsigned char* ws, LASP float* E, int s, int g, int dir, int wave, int lane) {
    const int nch = 8 * SEG, ch0 = s == 2 ? 256 : s * 128;
    const float dt = __expf(p.in[10][dir * NG + g]); const int li = (dir * NG + g) * 64 + lane;
    const float a = p.in[8][li] * dt, brev = p.in[9][li] * dt * 0.15915494309189535f;
    const cf lT = lam_pow(a, brev, (float)TCH), lTS = lam_pow(a, brev, (float)(TCH * SEG));
    const float* sb = (const float*)(ws + WS_SBUF) + ((size_t)g * NCHUNK + ch0) * 256 + dir * 128 + lane;
    bf16_t* cb = (bf16_t*)(ws + WS_UG) + ((size_t)g * NCHUNK + ch0) * 768 + 512 + dir * 128 + lane;
    const int k0 = dir == 0 ? wave * SEG : nch - 1 - wave * SEG;
    const long stS = dir == 0 ? 256 : -256, stC = dir == 0 ? 768 : -768;
    const float* ps = sb + (long)k0 * 256; bf16_t* pc = cb + (long)k0 * 768;
    cf x{0.f, 0.f};
#pragma unroll 1
    for (int b0 = 0; b0 < SEG; b0 += 16) {
        float sre[16], sim[16];
#pragma unroll
        for (int e = 0; e < 16; ++e) { sre[e] = ps[0]; sim[e] = ps[64]; ps += stS; }
#pragma unroll
        for (int e = 0; e < 16; ++e) { const cf nx = cmul(lT, x); x.re = nx.re + sre[e]; x.im = nx.im + sim[e]; }
    }
    E[(wave * 64 + lane) * 2] = x.re; E[(wave * 64 + lane) * 2 + 1] = x.im;
    __syncthreads();
    cf c{0.f, 0.f};
    for (int v = 0; v < wave; ++v) { const cf nx = cmul(lTS, c); c.re = nx.re + E[(v * 64 + lane) * 2]; c.im = nx.im + E[(v * 64 + lane) * 2 + 1]; }
    x = c; ps = sb + (long)k0 * 256;
#pragma unroll 1
    for (int b0 = 0; b0 < SEG; b0 += 16) {
        float sre[16], sim[16];
#pragma unroll
        for (int e = 0; e < 16; ++e) { sre[e] = ps[0]; sim[e] = ps[64]; ps += stS; }
#pragma unroll
        for (int e = 0; e < 16; ++e) {
            pc[0] = (bf16_t)f2bf(x.re); pc[64] = (bf16_t)f2bf(x.im); pc += stC;
            const cf nx = cmul(lT, x); x.re = nx.re + sre[e]; x.im = nx.im + sim[e]; }
    }
}
#define rsq_q ((float*)(ws + WS_RSQQ))
#define rsq_kv ((float*)(ws + WS_RSQKV))
#define rsq_a ((float*)(ws + WS_RSQA))
#define rsq_s ((float*)(ws + WS_RSQS))
#define rsq_x ((float*)(ws + WS_RSQX))
#define ROPE ((float*)(ws + WS_ROPE))
#define KT ((float*)(ws + WS_KT))
#define Wgu ((bf16_t*)(ws + WS_WGU))
#define Wdown ((bf16_t*)(ws + WS_WDOWN))
#define Win ((bf16_t*)(ws + WS_WIN))
#define Wqb ((bf16_t*)(ws + WS_WQB))
#define Wkvb ((bf16_t*)(ws + WS_WKVB))
#define Wglu ((bf16_t*)(ws + WS_WGLU))
#define Wout ((bf16_t*)(ws + WS_WOUT))
#define KW ((bf16_t*)(ws + WS_KW))
#define Wst ((bf16_t*)(ws + WS_WST))
#define XN ((bf16_t*)(ws + WS_XN))
#define KV ((bf16_t*)(ws + WS_KV))
#define KRB ((bf16_t*)(ws + WS_KR))
#define MB ((bf16_t*)(ws + WS_MB))
#define CQ ((bf16_t*)(ws + WS_CQ))
#define CKV ((bf16_t*)(ws + WS_CKV))
#define UG ((bf16_t*)(ws + WS_UG))
#define MIX ((bf16_t*)(ws + WS_MIX))
#define QBUF ((bf16_t*)(ws + WS_Q))
#define SBUF ((float*)(ws + WS_SBUF))
#define Yb ((bf16_t*)(ws + WS_Y))
#define Hb ((bf16_t*)(ws + WS_H))
#define Fb ((bf16_t*)(ws + WS_F))
#define HMID ((bf16_t*)(ws + WS_HMID))
#define lam_re (p.in[8])
#define lam_im (p.in[9])
#define log_dt (p.in[10])
#define b_re (p.in[11])
#define b_im (p.in[12])
#define c_re (p.in[13])
#define c_im (p.in[14])
#define ssm_d (p.in[15])
__global__ void __launch_bounds__(512, 2) fwd_megakernel(Params p) {
    extern __shared__ __attribute__((aligned(16))) unsigned char lds[];
    cg::grid_group grid = cg::this_grid();
    const int tid = threadIdx.x, lane = tid & 63, wave = __builtin_amdgcn_readfirstlane(tid >> 6);
    const int G = gridDim.x, bid = blockIdx.x;
    const int gw = bid * 8 + wave, NGW = G * 8, gt = bid * 512 + tid, NGT = G * 512;
    unsigned char* ws = p.ws;
    LASP unsigned char* ldsl = (LASP unsigned char*)lds;
    volatile LASP unsigned* bst = (volatile LASP unsigned*)(ldsl + LDS_BYTES - 16);
    if (tid < 4) bst[tid] = 0u;
    __syncthreads();
    const XcdBarrier xbar = xcd_barrier_post((unsigned*)(ws + WS_BAR), bst);

    PH_ON(0) {
        for (int i = gt; i < MROWS; i += NGT) { rsq_q[i] = 0.f; rsq_kv[i] = 0.f; rsq_a[i] = 0.f; rsq_s[i] = 0.f; }
        for (int i = gt; i < LS * 32; i += NGT) { const int pos = i >> 5, j = i & 31;
            const float inv = __builtin_amdgcn_exp2f(-(float)j * (13.287712379549449f / 32.f));
            const float ang = (float)pos * inv; const double rv = (double)ang * 0.15915494309189535; const float fr = (float)(rv - __builtin_rint(rv));
            ROPE[2 * i] = __builtin_amdgcn_cosf(fr); ROPE[2 * i + 1] = __builtin_amdgcn_sinf(fr); }
        for (int i = gt; i < 192 * DM / 8; i += NGT) *(u32x4*)(Win + (size_t)1856 * DM + (size_t)i * 8) = (u32x4){0u, 0u, 0u, 0u};
        LASP float* scr = (LASP float*)(ldsl + wave * 16384);
        constexpr int I_IN = (DM / 64) * (1856 / 32), I_QB = (512 / 64) * (1536 / 32), I_KVB = (256 / 64) * (2048 / 32), I_GLU = (1024 / 64) * (1024 / 32), I_OUT = (DM / 64) * (DM / 32);
        constexpr int I_G = (DM / 64) * (DFF / 32), I_D = (DFF / 64) * (DM / 32);
        constexpr int NITEMS = I_IN + I_QB + I_KVB + I_GLU + I_OUT;
        for (int it = gw; it < NITEMS; it += NGW) {
            int r = it;
            if (r < I_IN) { transpose_item(p.in[3], DM, 1856, Win, 1, nullptr, scr, r, lane); continue; } r -= I_IN;
            if (r < I_QB) { transpose_item(p.in[5], 512, 1536, Wqb, 2, p.in[4], scr, r, lane); continue; } r -= I_QB;
            if (r < I_KVB) { transpose_item(p.in[7], 256, 2048, Wkvb, 0, p.in[6], scr, r, lane); continue; } r -= I_KVB;
            if (r < I_GLU) { transpose_item(p.in[16], 1024, 1024, Wglu, 0, nullptr, scr, r, lane); continue; } r -= I_GLU;
            transpose_item(p.in[20], DM, DM, Wout, 0, (64 * (r / (DM / 32))) < 1024 ? p.in[18] : p.in[19] - 1024, scr, r, lane);
        }
        {
            const float* gpm = p.in[2];
            f32x4 gv[8];
#pragma unroll
            for (int j = 0; j < 8; ++j) gv[j] = *(const f32x4*)(gpm + 4 * lane + 256 * j);
            f32x4 v[8], nv[8];
            { const f32x4* xr = (const f32x4*)xrow_ptr(p, gw) + lane;
#pragma unroll
              for (int j = 0; j < 8; ++j) nv[j] = xr[64 * j]; }
            for (int m = gw; m < MROWS; m += NGW) {
                float s = 0.f;
#pragma unroll
                for (int j = 0; j < 8; ++j) { v[j] = nv[j]; s += (v[j].x * v[j].x + v[j].y * v[j].y) + (v[j].z * v[j].z + v[j].w * v[j].w); }
                if (m + NGW < MROWS) { const f32x4* xr = (const f32x4*)xrow_ptr(p, m + NGW) + lane;
#pragma unroll
                  for (int j = 0; j < 8; ++j) nv[j] = xr[64 * j]; }
                const float rstd = 1.f / sqrtf(wave_sum(s) * (1.f / DM) + RMS_EPS);
                u32x2* o8 = (u32x2*)(XN + (size_t)m * DM) + lane;
#pragma unroll
                for (int j = 0; j < 8; ++j) { const f32x4 w = v[j] * rstd * gv[j]; u32x2 o; o.x = pk2(w.x, w.y); o.y = pk2(w.z, w.w); o8[64 * j] = o; }
            }
        }
        for (int wi = wave * G + bid; wi < 2048 + 2048; wi += 8 * G) {
            if (wi < 2048) {
                const int i = wi * 64 + lane;
                const int ps = i & 3, cc = (i >> 2) & 15, c = (i >> 6) & 15, dir = (i >> 10) & 1, g = i >> 11;
                const float dt = __expf(log_dt[dir * NG + g]);
                float accd[TCH];
#pragma unroll
                for (int d = 0; d < TCH; ++d) accd[d] = 0.f;
#pragma unroll 4
                for (int pq = 0; pq < 16; ++pq) {
                    const int pp = ps * 16 + pq;
                    const int li = (dir * NG + g) * 64 + pp; const float lre = lam_re[li], lim = lam_im[li];
                    const cf coef = zoh_coef(lre, lim, dt);
                    const cf bt = cmul(coef, cf{b_re[(size_t)li * 16 + cc], b_im[(size_t)li * 16 + cc]});
                    const size_t ci = ((size_t)(dir * NG + g) * 16 + c) * 64 + pp;
                    cf z = cmul(cf{c_re[ci], c_im[ci]}, bt);
                    const cf lb = lam_pow(lre * dt, lim * dt * 0.15915494309189535f, 1.f);
#pragma unroll
                    for (int d = 0; d < TCH; ++d) { accd[d] += z.re; z = cmul(z, lb); }
                }
#pragma unroll
                for (int d = 0; d < TCH; ++d) { float v = accd[d]; v += __shfl_xor(v, 1); v += __shfl_xor(v, 2); accd[d] = v; }
                if (ps == 0) {
#pragma unroll
                    for (int d = 0; d < TCH; ++d) KT[(((size_t)(g * 2 + dir) * TCH + d) * 16 + c) * 16 + cc] = accd[d];
                }
            } else {
                const int sub = (wi - 2048) >> 10, jq = (wi - 2048) & 7, i = (((wi - 2048) & 1023) >> 3) * 64 + lane;
                const int pp = i & 63, dir = (i >> 6) & 1, g = i >> 7;
                const float dt = __expf(log_dt[dir * NG + g]);
                const int li = (dir * NG + g) * 64 + pp; const float lre = lam_re[li], lim = lam_im[li];
                const float a = lre * dt, brev = lim * dt * 0.15915494309189535f;
                if (sub == 0) {
                    const cf coef = zoh_coef(lre, lim, dt);
                    bf16_t* wre = Wst + ((size_t)g * 256 + dir * 128 + pp) * 512; bf16_t* wim = wre + 64 * 512;
                    cf bt[16];
#pragma unroll
                    for (int cc = 0; cc < 16; ++cc) bt[cc] = cmul(coef, cf{b_re[(size_t)li * 16 + cc], b_im[(size_t)li * 16 + cc]});
                    for (int j = 4 * jq; j < 4 * jq + 4; ++j) {
                        const cf lp = lam_pow(a, brev, dir == 0 ? (float)(TCH - 1 - j) : (float)j);
                        float vr[16], vi[16];
#pragma unroll
                        for (int cc = 0; cc < 16; ++cc) { const cf z = cmul(lp, bt[cc]); vr[cc] = z.re; vi[cc] = z.im; }
#pragma unroll
                        for (int h = 0; h < 2; ++h) {
                            u32x4 o; o.x = pk2(vr[8 * h + 0], vr[8 * h + 1]); o.y = pk2(vr[8 * h + 2], vr[8 * h + 3]); o.z = pk2(vr[8 * h + 4], vr[8 * h + 5]); o.w = pk2(vr[8 * h + 6], vr[8 * h + 7]);
                            *(u32x4*)(wre + j * 16 + 8 * h) = o;
                            o.x = pk2(vi[8 * h + 0], vi[8 * h + 1]); o.y = pk2(vi[8 * h + 2], vi[8 * h + 3]); o.z = pk2(vi[8 * h + 4], vi[8 * h + 5]); o.w = pk2(vi[8 * h + 6], vi[8 * h + 7]);
                            *(u32x4*)(wim + j * 16 + 8 * h) = o; }
                    }
                } else {
                    cf cv[16];
#pragma unroll
                    for (int c = 0; c < 16; ++c) { const size_t ci = ((size_t)(dir * NG + g) * 16 + c) * 64 + pp; cv[c] = cf{c_re[ci], c_im[ci]}; }
                    for (int ii = 4 * jq; ii < 4 * jq + 4; ++ii) {
                        const cf lp = lam_pow(a, brev, dir == 0 ? (float)(ii + 1) : (float)(TCH - ii));
#pragma unroll
                        for (int c = 0; c < 16; ++c) { const cf z = cmul(cv[c], lp);
                            bf16_t* kr = KW + ((size_t)g * 512 + ii * 16 + c) * 768 + 512 + dir * 128 + pp;
                            kr[0] = (bf16_t)f2bf(z.re); kr[64] = (bf16_t)f2bf(-z.im); }
                    }
                }
            }
        }
    }
    xcd_barrier(xbar);
    if (p.ws == nullptr) grid.sync();

    PH_ON(1) {
        for (int i = gt; i < NG * 512 * 64; i += NGT) {
            const int c8 = i & 1, j = (i >> 1) & 31, c = (i >> 6) & 15, ii = (i >> 10) & 31, g = i >> 15;
            float v[8];
            if (j < ii) { const float* s = KT + (((size_t)(g * 2 + 0) * TCH + (ii - j)) * 16 + c) * 16 + 8 * c8;
#pragma unroll
                for (int e = 0; e < 8; ++e) v[e] = s[e]; }
            else if (j > ii) { const float* s = KT + (((size_t)(g * 2 + 1) * TCH + (j - ii)) * 16 + c) * 16 + 8 * c8;
#pragma unroll
                for (int e = 0; e < 8; ++e) v[e] = s[e]; }
            else { const float* s0 = KT + (((size_t)(g * 2 + 0) * TCH) * 16 + c) * 16 + 8 * c8; const float* s1 = KT + (((size_t)(g * 2 + 1) * TCH) * 16 + c) * 16 + 8 * c8;
#pragma unroll
                for (int e = 0; e < 8; ++e) v[e] = s0[e] + s1[e] + ((8 * c8 + e) == c ? ssm_d[g * 16 + c] : 0.f); }
            u32x4 o; o.x = pk2(v[0], v[1]); o.y = pk2(v[2], v[3]); o.z = pk2(v[4], v[5]); o.w = pk2(v[6], v[7]);
            *(u32x4*)(KW + ((size_t)g * 512 + ii * 16 + c) * 768 + j * 16 + 8 * c8) = o;
        }
        pg8::Gemm g{XN, Win, DM, DM, DM, 0, 0}; pg8::StaticOrder S; S.init(MROWS, 2048, G, bid);
        EpiInProj E{CQ, CKV, UG, KRB, rsq_q, rsq_kv, ROPE};
        pg8::gemm_phase<EpiInProj, pg8::StaticOrder>(ldsl, g, S, E);
    }
    xcd_barrier(xbar);

    PH_ON(2) {
        for (int i = gt; i < MROWS * 8; i += NGT) { const int row = i >> 3, c = (i & 7) * 8; *(u32x4*)(KV + (size_t)row * 2112 + 2048 + c) = *(const u32x4*)(KRB + (size_t)row * 64 + c); }
#ifndef NO_SG
        { pg8::Gemm g{UG, Wst, 768, 512, 512, (long)NCHUNK * 768, 256L * 512}; pg8::GroupOrder S; S.init(NCHUNK / 256, 1, NG, G, bid); EpiS E{SBUF};
          pg8::gemm_phase<EpiS, pg8::GroupOrder>(ldsl, g, S, E); }
#endif
#ifndef NO_QB
        { pg8::Gemm g{CQ, Wqb, 512, 512, 512, 0, 0}; pg8::StaticOrder S; S.init(MROWS, 1536, G, G - 1 - bid);     EpiQ E{QBUF, rsq_q, ROPE};
          pg8::gemm_phase<EpiQ, pg8::StaticOrder>(ldsl, g, S, E); }
#endif
#ifndef NO_KVB
        { pg8::Gemm g{CKV, Wkvb, 256, 256, 256, 0, 0}; pg8::StaticOrder S; S.init(MROWS, 2048, G, bid); EpiScaleRow E{KV, 2112, rsq_kv, 1.f / 256.f};
          pg8::gemm_phase<EpiScaleRow, pg8::StaticOrder>(ldsl, g, S, E); }
#endif
    }
    xcd_barrier(xbar);

    PH_ON(3) {
        for (int slot = 0; slot < 2; ++slot) {
            int it;
            if (bid < 128) { if (slot) break; it = bid; } else { it = 128 + (bid - 128) * 2 + slot; }
            if (it < 128) scan_item<64>(p, ws, (LASP float*)ldsl, 2, it >> 1, it & 1, wave, lane);
            else { const int r = it - 128; scan_item<16>(p, ws, (LASP float*)ldsl, r >> 7, (r & 127) >> 1, r & 1, wave, lane); }
            __syncthreads();
        }
    }
    xcd_barrier(xbar);

    PH_ON(4) {
        pg8::Gemm g{UG, KW, 768, 768, 768, (long)NCHUNK * 768, 512L * 768}; pg8::GroupOrder S; S.init(NCHUNK / 256, 2, NG, G, bid); EpiY E{Yb};
        pg8::gemm_phase<EpiY, pg8::GroupOrder>(ldsl, g, S, E);
        if (bid >= 128) ffn_weight_items(p, ws, ldsl, 0, 8448, bid, wave, lane);
    }
    xcd_barrier(xbar);

    PH_ON(5) {
#ifndef NO_GLU
        { pg8::Gemm g{Yb, Wglu, 1024, 1024, 1024, 0, 0}; pg8::StaticOrder S; S.init(MROWS, 1024, G, bid); EpiGlu E{Yb, p.in[17], MIX, rsq_s};
          pg8::gemm_phase<EpiGlu, pg8::StaticOrder>(ldsl, g, S, E); }
#endif
        if (bid >= 128) ffn_weight_items(p, ws, ldsl, 8448, 16896, bid, wave, lane);
        __syncthreads();
        const int h = bid & 7, idx = bid >> 3;
#ifndef NO_ATT
        for (int rep = 0; rep < ATT_REP; ++rep)
        for (int uu = 0; uu < 3; ++uu) {
            int row0, qb, seq;
            if (uu < 2) { row0 = MPROMPT; seq = LS; qb = (idx * 2 + uu) % 64; if (idx >= 32) {   } }
            else { row0 = (idx >> 4) * LP; seq = LP; qb = idx & 15; }
            if (G == 256 || true) {
                const bf16_t* Qp = QBUF + (size_t)(row0 + qb * 256) * 1536 + h * QKD;
                const bf16_t* Kp = KV + (size_t)row0 * 2112;
                bf16_t* Op = MIX + (size_t)(row0 + qb * 256) * 2048 + h * 128;
                att::attn_body(Qp, Kp, h * 256, Op, rsq_a + row0 + qb * 256, seq, (char*)lds);
                __syncthreads();
            }
        }
#endif
    }
    xcd_barrier(xbar);

    PH_ON(7) {
        pg8::Gemm g{MIX, Wout, DM, DM, DM, 0, 0}; pg8::StaticOrder S; S.init(MROWS, DM, G, bid); EpiOutProj E{MB, rsq_a, rsq_s};
        pg8::gemm_phase<EpiOutProj, pg8::StaticOrder>(ldsl, g, S, E);
    }
    xcd_barrier(xbar);

    PH_ON(8) {
        const float* gpo = p.in[21];
        for (int m = gw; m < MROWS; m += NGW) {
            const u32x2* r8 = (const u32x2*)(MB + (size_t)m * DM) + lane; const f32x4* xr = (const f32x4*)xrow_ptr(p, m) + lane; f32x4 v[8]; float s = 0.f;
#pragma unroll
            for (int j = 0; j < 8; ++j) { const u32x2 w = r8[64 * j]; v[j] = (f32x4){__uint_as_float(w.x << 16), __uint_as_float(w.x & 0xffff0000u), __uint_as_float(w.y << 16), __uint_as_float(w.y & 0xffff0000u)};
                s += (v[j].x * v[j].x + v[j].y * v[j].y) + (v[j].z * v[j].z + v[j].w * v[j].w); }
            const float rm = 1.f / sqrtf(wave_sum(s) * (1.f / DM) + RMS_EPS); float s1 = 0.f;
            u32x2* h8 = (u32x2*)(Hb + (size_t)m * DM) + lane;
#pragma unroll
            for (int j = 0; j < 8; ++j) { const f32x4 gg = *(const f32x4*)(gpo + 4 * lane + 256 * j); v[j] = xr[64 * j] + v[j] * rm * gg;
                s1 += (v[j].x * v[j].x + v[j].y * v[j].y) + (v[j].z * v[j].z + v[j].w * v[j].w);
                u32x2 o; o.x = pk2(v[j].x, v[j].y); o.y = pk2(v[j].z, v[j].w); h8[64 * j] = o; }
            s1 = wave_sum(s1);
            if (lane == 0) rsq_x[m] = s1;
        }
    }
    xcd_barrier(xbar);

    PH_ON(9) {
        pg8::Gemm g{Hb, Wgu, DM, DM, DM, 0, 0}; pg8::StaticOrder S; S.init(MROWS, 2 * DFF, G, bid); EpiFfn E{HMID, rsq_x};
        for (int frep = 0; frep < FFN_REP; ++frep) pg8::gemm_phase<EpiFfn, pg8::StaticOrder>(ldsl, g, S, E);
    }
    xcd_barrier(xbar);

    PH_ON(10) {
        pg8::Gemm g{HMID, Wdown, DFF, DFF, DFF, 0, 0}; pg8::StaticOrder S; S.init(MROWS, DM, G, bid); EpiScaleRow E{(bf16_t*)p.out, 2 * DM, nullptr, 0.f};
        for (int frep = 0; frep < FFN_REP; ++frep) pg8::gemm_phase<EpiScaleRow, pg8::StaticOrder>(ldsl, g, S, E);
    }
    xcd_barrier(xbar);

    PH_ON(11) {
        const float* gpf = p.in[26];
        for (int m = gw; m < MROWS; m += NGW) {
            const u32x2* r8 = (const u32x2*)((const bf16_t*)p.out + (size_t)m * 2 * DM) + lane; const u32x2* x8 = (const u32x2*)(Hb + (size_t)m * DM) + lane; f32x4 v[8]; u32x2 xb[8]; float s = 0.f;
#pragma unroll
            for (int j = 0; j < 8; ++j) { const u32x2 w = r8[64 * j]; xb[j] = x8[64 * j]; v[j] = (f32x4){__uint_as_float(w.x << 16), __uint_as_float(w.x & 0xffff0000u), __uint_as_float(w.y << 16), __uint_as_float(w.y & 0xffff0000u)};
                s += (v[j].x * v[j].x + v[j].y * v[j].y) + (v[j].z * v[j].z + v[j].w * v[j].w); }
            const float rf = 1.f / sqrtf(wave_sum(s) * (1.f / DM) + RMS_EPS);
            f32x4* orow = (f32x4*)(p.out + (size_t)m * DM) + lane;
#pragma unroll
            for (int j = 0; j < 8; ++j) { const f32x4 gg = *(const f32x4*)(gpf + 4 * lane + 256 * j);
                const f32x4 x1 = (f32x4){__uint_as_float(xb[j].x << 16), __uint_as_float(xb[j].x & 0xffff0000u), __uint_as_float(xb[j].y << 16), __uint_as_float(xb[j].y & 0xffff0000u)};
                orow[64 * j] = x1 + v[j] * rf * gg; }
        }
    }
}

extern "C" void kernel_launch(void* const* d_in, const int* in_sizes, int n_in, void* d_out, int out_size, void* d_ws, size_t ws_size, hipStream_t stream) {
    static int grid = 0;
    if (grid == 0) {
        if (n_in != 27 || ws_size < WS_END) { fprintf(stderr, "kernel_launch: unexpected n_in %d / ws_size %zu\n", n_in, ws_size); grid = -1; return; }
        int dev = 0, cus = 0, per_cu = 0;
        hipGetDevice(&dev); hipDeviceGetAttribute(&cus, hipDeviceAttributeMultiprocessorCount, dev);
        hipFuncSetAttribute((const void*)fwd_megakernel, hipFuncAttributeMaxDynamicSharedMemorySize, LDS_BYTES);
        hipOccupancyMaxActiveBlocksPerMultiprocessor(&per_cu, (const void*)fwd_megakernel, 512, LDS_BYTES);
        if (per_cu < 1) { fprintf(stderr, "kernel_launch: occupancy query says %d blocks per CU\n", per_cu); per_cu = 1; }
        (void)hipGetLastError();
        grid = 256;
        if (cus < 256) fprintf(stderr, "kernel_launch: %d CUs (built for 256): the cooperative launch will be rejected\n", cus);
    }
    if (grid < 0) return;
    Params p{};
    for (int i = 0; i < 27; ++i) p.in[i] = (const float*)d_in[i];
    p.out = (float*)d_out; p.ws = (unsigned char*)d_ws;
    (void)hipMemsetAsync((char*)d_ws + WS_BAR, 0, BAR_BYTES, stream);
    void* args[] = {&p};
    hipError_t e = hipLaunchCooperativeKernel((const void*)fwd_megakernel, dim3(grid), dim3(512), args, LDS_BYTES, stream);
    if (e != hipSuccess) fprintf(stderr, "cooperative launch failed: %s (grid %d)\n", hipGetErrorString(e), grid);
}
```

```cpp
#include <hip/hip_runtime.h>
#include <hip/hip_cooperative_groups.h>
#include <cstdint>
#include <cstdio>
namespace cg = cooperative_groups;

constexpr int DM = 2048, MROWS = 24576, MPROMPT = 8192, LP = 4096, LS = 16384;
constexpr int NH = 8, QKD = 192, DFF = 5632;
constexpr int TCH = 32, NCHUNK = MROWS / TCH  , NG = 64;
constexpr float RMS_EPS = 1e-6f;

namespace pg8 {
#define PG8_LAS __attribute__((address_space(3)))
typedef unsigned short bf16_t;
typedef short bf16x8 __attribute__((ext_vector_type(8)));
typedef float f32x4 __attribute__((ext_vector_type(4)));
typedef unsigned u32x4 __attribute__((ext_vector_type(4)));
constexpr int BM = 256, BK = 64, HALF = 128, HTB = HALF * BK * 2, STAGE_BYTES = 8 * HTB, NXCD = 8, WGM = 8;

__host__ __device__ __forceinline__ int lds_byte(int r, int c) { const int st = (r >> 4) * 2 + (c >> 5), rr = r & 15, cc = c & 31, ob = rr * 64 + cc * 2; return st * 1024 + (ob ^ (((ob >> 9) & 1) << 5)); }
__host__ __device__ __forceinline__ void stage_rc(int b, int& R, int& C) { const int st = b / 1024, sb = b % 1024, swz = sb ^ (((sb >> 9) & 1) << 5); R = (st >> 1) * 16 + swz / 64; C = (st & 1) * 32 + (swz % 64) / 2; }
__host__ __device__ __forceinline__ int perm32(int rho) { const int n = rho >> 4, i = rho & 15; return 8 * (i >> 2) + 4 * n + (i & 3); }

struct Unit { int pm, pn, g; };
struct Gemm { const bf16_t* A; const bf16_t* Bt; int lda, ldb, K; long gsA, gsB; };

struct StaticOrder {
    int nM, nN, nwg, G, c;
    __device__ void init(int M, int N, int G_, int c_) { nM = M / BM; nN = N / BM; nwg = nM * nN; G = G_; c = c_; }
    __device__ bool next(int i, Unit& u) const {
        const long L = (long)i * G + c; if (L >= nwg) return false;
        int wgid = (int)L; { const int q = nwg / NXCD, r = nwg % NXCD, xcd = wgid % NXCD, off = wgid / NXCD; wgid = (xcd < r ? xcd * (q + 1) : r * (q + 1) + (xcd - r) * q) + off; }
        const int nig = WGM * nN, gid = wgid / nig, fm = gid * WGM, gsz = (nM - fm) < WGM ? (nM - fm) : WGM;
        u.pm = fm + ((wgid % nig) % gsz); u.pn = (wgid % nig) / gsz; u.g = 0; return true;
    }
};
struct GroupOrder {
    int nM, nN, per, total, G, c;
    __device__ void init(int nM_, int nN_, int ng, int G_, int c_) { nM = nM_; nN = nN_; per = nM * nN; total = per * ng; G = G_; c = c_; }
    __device__ bool next(int i, Unit& u) const {
        const int L = i * G + c; if (L >= total) return false;
        u.g = L / per; const int r = L % per; u.pn = r / nM; u.pm = r % nM; return true;
    }
};

__device__ __forceinline__ unsigned cvt_pk_bf16(float lo, float hi) { unsigned r; asm volatile("v_cvt_pk_bf16_f32 %0, %1, %2" : "=v"(r) : "v"(lo), "v"(hi)); return r; }
__device__ __forceinline__ u32x4 pack8(f32x4 v0, f32x4 v1) { u32x4 w; w.x = cvt_pk_bf16(v0[0], v0[1]); w.y = cvt_pk_bf16(v0[2], v0[3]); w.z = cvt_pk_bf16(v1[0], v1[1]); w.w = cvt_pk_bf16(v1[2], v1[3]); return w; }

template <class Epi, class Sched, bool ALIGN_EPI = true>
__device__ __forceinline__ void gemm_phase(PG8_LAS unsigned char* lds, const Gemm g, const Sched& S, const Epi& E) {
    int tid_ = threadIdx.x; asm volatile("" : "+v"(tid_));
    const int tid = tid_, wid = __builtin_amdgcn_readfirstlane(tid >> 6), lane = tid & 63, wr = wid >> 2, wc = wid & 3, fr = lane & 15, fq = lane >> 4;
    const int K = g.K, nt = K / BK;
    unsigned voffA[2], voffB[2];
#pragma unroll
    for (int i = 0; i < 2; ++i) { int R, C; stage_rc(tid * 16 + i * 8192, R, C); const int Rb = (R & ~31) + perm32(R & 31);
        voffA[i] = (unsigned)(R * g.lda + C) * 2u; voffB[i] = (unsigned)(Rb * g.ldb + C) * 2u; }
    const unsigned kstep = (unsigned)(BK * 2);
    const unsigned hstepA = (unsigned)(HALF * g.lda * 2), hstepB = (unsigned)(HALF * g.ldb * 2);
    const auto srdA = __builtin_amdgcn_make_buffer_rsrc((void*)g.A, (short)0, 0x7fffffff, 0x00020000);
    const auto srdB = __builtin_amdgcn_make_buffer_rsrc((void*)g.Bt, (short)0, 0x7fffffff, 0x00020000);
    const unsigned ldsw = (unsigned)wid * 1024u;
    const int aoff = lds_byte(wr * 64 + fr, fq * 8), boff = lds_byte(wc * 32 + fr, fq * 8);
#define PG8_SA(b, h) (((b) * 2 + (h)) * HTB)
#define PG8_SB(b, h) ((4 + (b) * 2 + (h)) * HTB)
#define PG8_STAGE(srd, bufoff, goff, voff) do { _Pragma("unroll") for (int _i = 0; _i < 2; ++_i) \
        __builtin_amdgcn_raw_ptr_buffer_load_lds(srd, (PG8_LAS unsigned*)(lds + (bufoff) + ldsw + _i * 8192), 16, (voff)[_i], (goff), 0, 0); } while (0)
#define PG8_LDA(dst, b, h) do { _Pragma("unroll") for (int m = 0; m < 4; ++m) _Pragma("unroll") for (int k = 0; k < 2; ++k) dst[m][k] = *(const PG8_LAS bf16x8*)(lds + PG8_SA(b, h) + aoff + m * 2048 + k * 1024); } while (0)
#define PG8_LDB(dst, b, h) do { _Pragma("unroll") for (int n = 0; n < 2; ++n) _Pragma("unroll") for (int k = 0; k < 2; ++k) dst[n][k] = *(const PG8_LAS bf16x8*)(lds + PG8_SB(b, h) + boff + n * 2048 + k * 1024); } while (0)
#define PG8_MMA(ai, bj, At, Bt) do { __builtin_amdgcn_s_setprio(1); _Pragma("unroll") for (int m = 0; m < 4; ++m) _Pragma("unroll") for (int n = 0; n < 2; ++n) _Pragma("unroll") for (int k = 0; k < 2; ++k) \
        acc[ai][bj][m][n] = __builtin_amdgcn_mfma_f32_16x16x32_bf16(Bt[n][k], At[m][k], acc[ai][bj][m][n], 0, 0, 0); __builtin_amdgcn_s_setprio(0); } while (0)
#define PG8_WAIT_V(n) asm volatile("s_waitcnt vmcnt(" #n ")" ::: "memory")
#define PG8_WAIT_L(n) asm volatile("s_waitcnt lgkmcnt(" #n ")" ::: "memory")
#define PG8_BAR __builtin_amdgcn_s_barrier()
#define PG8_SCHED __builtin_amdgcn_sched_barrier(0)
#define PG8_BASEA(u) ((unsigned)(((size_t)(u).g * g.gsA + (size_t)(u).pm * BM * g.lda) * 2))
#define PG8_BASEB(u) ((unsigned)(((size_t)(u).g * g.gsB + (size_t)(u).pn * BM * g.ldb) * 2))
    Unit cur, nxt; int ui = 0;
    if (!S.next(0, cur)) return;
    f32x4 acc[2][2][4][2];
#pragma unroll
    for (int a = 0; a < 2; ++a)
#pragma unroll
        for (int b = 0; b < 2; ++b)
#pragma unroll
            for (int m = 0; m < 4; ++m)
#pragma unroll
                for (int n = 0; n < 2; ++n) acc[a][b][m][n] = (f32x4){0.f, 0.f, 0.f, 0.f};
    bf16x8 At[4][2], B0[2][2], B1[2][2];
    unsigned cA = PG8_BASEA(cur), cB = PG8_BASEB(cur);
    PG8_STAGE(srdB, PG8_SB(0, 0), cB, voffB); PG8_STAGE(srdB, PG8_SB(0, 1), cB + hstepB, voffB); PG8_STAGE(srdA, PG8_SA(0, 0), cA, voffA); PG8_STAGE(srdA, PG8_SA(0, 1), cA + hstepA, voffA);
    if (wr == 1) PG8_BAR;
    PG8_WAIT_V(2); PG8_BAR;
    PG8_STAGE(srdB, PG8_SB(1, 0), cB + kstep, voffB); PG8_STAGE(srdA, PG8_SA(1, 0), cA + kstep, voffA); PG8_STAGE(srdB, PG8_SB(1, 1), cB + hstepB + kstep, voffB);
    PG8_WAIT_V(6); PG8_BAR;
    for (;;) {
        const bool has_next = S.next(ui + 1, nxt);
        const unsigned nA = has_next ? PG8_BASEA(nxt) : cA, nB = has_next ? PG8_BASEB(nxt) : cB;
        for (int t = 0; t < nt; t += 2) {
            if constexpr (Epi::MID) { if (t == (nt >> 1)) E.mid(acc, cur, wr, fr); }
            const bool last = (t == nt - 2);
            const unsigned a1 = cA + (unsigned)(t + 1) * kstep;
            const unsigned a2 = last ? nA : cA + (unsigned)(t + 2) * kstep, b2 = last ? nB : cB + (unsigned)(t + 2) * kstep;
            const unsigned a3 = a2 + kstep, b3 = b2 + kstep;
            PG8_LDB(B0, 0, 0); PG8_LDB(B1, 0, 1); PG8_SCHED; PG8_LDA(At, 0, 0); PG8_STAGE(srdA, PG8_SA(1, 1), a1 + hstepA, voffA);
            PG8_WAIT_V(8); PG8_WAIT_L(0); PG8_BAR; PG8_MMA(0, 0, At, B0); PG8_MMA(0, 1, At, B1); PG8_BAR; PG8_SCHED;
            PG8_LDA(At, 0, 1); PG8_STAGE(srdB, PG8_SB(0, 0), b2, voffB); PG8_STAGE(srdB, PG8_SB(0, 1), b2 + hstepB, voffB); PG8_STAGE(srdA, PG8_SA(0, 0), a2, voffA);
            PG8_WAIT_V(8); PG8_WAIT_L(0); PG8_BAR; PG8_MMA(1, 0, At, B0); PG8_MMA(1, 1, At, B1); PG8_BAR; PG8_SCHED;
            PG8_LDB(B0, 1, 0); PG8_LDB(B1, 1, 1); PG8_SCHED; PG8_LDA(At, 1, 0); PG8_STAGE(srdA, PG8_SA(0, 1), a2 + hstepA, voffA);
            PG8_WAIT_V(8); PG8_WAIT_L(0); PG8_BAR; PG8_MMA(0, 0, At, B0); PG8_MMA(0, 1, At, B1); PG8_BAR; PG8_SCHED;
            PG8_LDA(At, 1, 1); PG8_STAGE(srdB, PG8_SB(1, 0), b3, voffB); PG8_STAGE(srdB, PG8_SB(1, 1), b3 + hstepB, voffB); PG8_STAGE(srdA, PG8_SA(1, 0), a3, voffA);
            PG8_WAIT_V(8); PG8_WAIT_L(0); PG8_BAR; PG8_MMA(1, 0, At, B0); PG8_MMA(1, 1, At, B1); PG8_BAR; PG8_SCHED;
        }
        if constexpr (ALIGN_EPI) { if (wr == 0) PG8_BAR; }
        E(acc, cur, wr, wc, fr, fq);
        if (!has_next) break;
#pragma unroll
        for (int a = 0; a < 2; ++a)
#pragma unroll
            for (int b = 0; b < 2; ++b)
#pragma unroll
                for (int m = 0; m < 4; ++m)
#pragma unroll
                    for (int n = 0; n < 2; ++n) acc[a][b][m][n] = (f32x4){0.f, 0.f, 0.f, 0.f};
        cur = nxt; cA = nA; cB = nB; ++ui;
        if constexpr (ALIGN_EPI) { if (wr == 1) PG8_BAR; }
    }
    PG8_WAIT_V(0);
    if constexpr (!ALIGN_EPI) { if (wr == 0) PG8_BAR; }
    PG8_BAR;
#undef PG8_SA
#undef PG8_SB
#undef PG8_STAGE
#undef PG8_LDA
#undef PG8_LDB
#undef PG8_MMA
#undef PG8_BAR
#undef PG8_SCHED
#undef PG8_BASEA
#undef PG8_BASEB
}
}

using pg8::bf16_t; using pg8::f32x4; using pg8::u32x4; using pg8::Unit; using pg8::pack8;
typedef float f32x2 __attribute__((ext_vector_type(2)));
typedef unsigned u32x2 __attribute__((ext_vector_type(2)));
#define LASP __attribute__((address_space(3)))

__device__ __forceinline__ float bf2f(unsigned short h) { return __uint_as_float(((unsigned)h) << 16); }
__device__ __forceinline__ float sigmoidf_(float x) { return __builtin_amdgcn_rcpf(1.f + __builtin_amdgcn_exp2f(-1.4426950408889634f * x)); }
__device__ __forceinline__ float gelu_tanh(float y) { const float in = 0.7978845608028654f * (y + 0.044715f * y * y * y); return y * sigmoidf_(2.f * in); }
__device__ __forceinline__ int seq_pos(int row) { return row < MPROMPT ? (row & (LP - 1)) : (row - MPROMPT); }
__device__ __forceinline__ void rope8(f32x4& v0, f32x4& v1, const float* cs) {
    const f32x4 c0 = *(const f32x4*)cs, c1 = *(const f32x4*)(cs + 4);
    f32x4 o0, o1;
    o0[0] = v0[0] * c0[0] - v0[1] * c0[1]; o0[1] = v0[1] * c0[0] + v0[0] * c0[1];
    o0[2] = v0[2] * c0[2] - v0[3] * c0[3]; o0[3] = v0[3] * c0[2] + v0[2] * c0[3];
    o1[0] = v1[0] * c1[0] - v1[1] * c1[1]; o1[1] = v1[1] * c1[0] + v1[0] * c1[1];
    o1[2] = v1[2] * c1[2] - v1[3] * c1[3]; o1[3] = v1[3] * c1[2] + v1[2] * c1[3];
    v0 = o0; v1 = o1;
}

#define EPI_ARGS const f32x4 (&acc)[2][2][4][2], const Unit& u, int wr, int wc, int fr, int fq
#define EPI_ROW(ai, m) (u.pm * 256 + (ai) * 128 + wr * 64 + (m) * 16 + fr)
#define EPI_COL(bj) (u.pn * 256 + (bj) * 128 + wc * 32 + 8 * fq)

struct EpiInProj {
    static constexpr bool MID = false;
    bf16_t* CQ; bf16_t* CKV; bf16_t* UG; bf16_t* KR; float* rsq_q; float* rsq_kv; const float* rope;
    __device__ __forceinline__ void operator()(EPI_ARGS) const {
        const int pn = u.pn;
        if (pn <= 2) {
            bf16_t* base = pn < 2 ? CQ : CKV; const int ld = pn < 2 ? 512 : 256, colt = pn < 2 ? pn * 256 : 0; float* rs = pn < 2 ? rsq_q : rsq_kv;
#pragma unroll
            for (int ai = 0; ai < 2; ++ai)
#pragma unroll
                for (int m = 0; m < 4; ++m) { const int row = EPI_ROW(ai, m); float ss = 0.f;
#pragma unroll
                    for (int bj = 0; bj < 2; ++bj) { const f32x4 v0 = acc[ai][bj][m][0], v1 = acc[ai][bj][m][1];
                        ss += (v0[0] * v0[0] + v0[1] * v0[1]) + (v0[2] * v0[2] + v0[3] * v0[3]) + (v1[0] * v1[0] + v1[1] * v1[1]) + (v1[2] * v1[2] + v1[3] * v1[3]);
                        *(u32x4*)(base + (size_t)row * ld + colt + bj * 128 + wc * 32 + 8 * fq) = pack8(v0, v1); }
                    ss += __shfl_xor(ss, 16); ss += __shfl_xor(ss, 32);
                    if (fq == 0) atomicAdd(rs + row, ss); }
        } else if (pn <= 6) {
#pragma unroll
            for (int ai = 0; ai < 2; ++ai)
#pragma unroll
                for (int m = 0; m < 4; ++m) { const int row = EPI_ROW(ai, m), k = row >> 5, i = row & 31;
#pragma unroll
                    for (int bj = 0; bj < 2; ++bj) { const int nu = (pn - 3) * 256 + bj * 128 + wc * 32 + 8 * fq, gg = nu >> 4, c0 = nu & 15;
                        *(u32x4*)(UG + ((size_t)(gg * NCHUNK + k)) * 768 + i * 16 + c0) = pack8(acc[ai][bj][m][0], acc[ai][bj][m][1]); } }
        } else {
            if (wc < 2) { const int col = wc * 32 + 8 * fq;
#pragma unroll
                for (int ai = 0; ai < 2; ++ai)
#pragma unroll
                    for (int m = 0; m < 4; ++m) { const int row = EPI_ROW(ai, m); f32x4 v0 = acc[ai][0][m][0], v1 = acc[ai][0][m][1];
                        rope8(v0, v1, rope + (size_t)seq_pos(row) * 64 + col);
                        *(u32x4*)(KR + (size_t)row * 64 + col) = pack8(v0, v1); } }
        }
    }
};
struct EpiQ {
    static constexpr bool MID = false;
    bf16_t* Q; const float* rsq; const float* rope;
    __device__ __forceinline__ void operator()(EPI_ARGS) const {
#pragma unroll
        for (int ai = 0; ai < 2; ++ai)
#pragma unroll
            for (int m = 0; m < 4; ++m) { const int row = EPI_ROW(ai, m); const float rstd = __builtin_amdgcn_rsqf(rsq[row] * (1.f / 512.f) + RMS_EPS) * 0.10411754f  ; const int pos = seq_pos(row);
#pragma unroll
                for (int bj = 0; bj < 2; ++bj) { const int col0 = EPI_COL(bj), d = col0 % QKD; f32x4 v0 = acc[ai][bj][m][0] * rstd, v1 = acc[ai][bj][m][1] * rstd;
                    if (d >= 128) rope8(v0, v1, rope + (size_t)pos * 64 + (d - 128));
                    *(u32x4*)(Q + (size_t)row * 1536 + col0) = pack8(v0, v1); } }
    }
};
struct EpiScaleRow {
    static constexpr bool MID = false;
    bf16_t* O; int ld; const float* rsq; float inv_n;
    __device__ __forceinline__ void operator()(EPI_ARGS) const {
#pragma unroll
        for (int ai = 0; ai < 2; ++ai)
#pragma unroll
            for (int m = 0; m < 4; ++m) { const int row = EPI_ROW(ai, m); const float rstd = rsq ? __builtin_amdgcn_rsqf(rsq[row] * inv_n + RMS_EPS) : 1.f;
#pragma unroll
                for (int bj = 0; bj < 2; ++bj) *(u32x4*)(O + (size_t)row * ld + EPI_COL(bj)) = pack8(acc[ai][bj][m][0] * rstd, acc[ai][bj][m][1] * rstd);
                asm volatile("" ::: "memory"); }
    }
};
struct EpiOutProj {
    static constexpr bool MID = true;
    bf16_t* O; const float* rsqa; const float* rsqs;
    __device__ __forceinline__ void mid(f32x4 (&acc)[2][2][4][2], const Unit& u, int wr, int fr) const {
        int rb = u.pm * 256 + wr * 64 + fr; asm volatile("" : "+v"(rb));
#pragma unroll
        for (int ai = 0; ai < 2; ++ai)
#pragma unroll
            for (int m = 0; m < 4; ++m) { const int row = rb + ai * 128 + m * 16;
                const float ra = __builtin_amdgcn_rsqf(rsqa[row] * (1.f / 1024.f) + RMS_EPS), rs = __builtin_amdgcn_rsqf(rsqs[row] * (1.f / 1024.f) + RMS_EPS); const float k = ra * __builtin_amdgcn_rcpf(rs);
#pragma unroll
                for (int bj = 0; bj < 2; ++bj) { acc[ai][bj][m][0] *= k; acc[ai][bj][m][1] *= k; }
                if (m & 1) asm volatile("" ::: "memory"); }
    }
    __device__ __forceinline__ void operator()(EPI_ARGS) const {
#pragma unroll
        for (int ai = 0; ai < 2; ++ai)
#pragma unroll
            for (int m = 0; m < 4; ++m) { const int row = EPI_ROW(ai, m); const float rs = __builtin_amdgcn_rsqf(rsqs[row] * (1.f / 1024.f) + RMS_EPS);
#pragma unroll
                for (int bj = 0; bj < 2; ++bj) *(u32x4*)(O + (size_t)row * 2048 + EPI_COL(bj)) = pack8(acc[ai][bj][m][0] * rs, acc[ai][bj][m][1] * rs);
                asm volatile("" ::: "memory"); }
    }
};
struct EpiS {
    static constexpr bool MID = false;
    float* S;
    __device__ __forceinline__ void operator()(EPI_ARGS) const {
#pragma unroll
        for (int ai = 0; ai < 2; ++ai)
#pragma unroll
            for (int m = 0; m < 4; ++m) { const int row = EPI_ROW(ai, m);
#pragma unroll
                for (int bj = 0; bj < 2; ++bj) { float* p = S + ((size_t)u.g * NCHUNK + row) * 256 + EPI_COL(bj); *(f32x4*)p = acc[ai][bj][m][0]; *(f32x4*)(p + 4) = acc[ai][bj][m][1]; }
                asm volatile("" ::: "memory"); }
    }
};
struct EpiY {
    static constexpr bool MID = false;
    bf16_t* Y;
    __device__ __forceinline__ void operator()(EPI_ARGS) const {
#pragma unroll
        for (int ai = 0; ai < 2; ++ai)
#pragma unroll
            for (int m = 0; m < 4; ++m) { const int row = EPI_ROW(ai, m);
#pragma unroll
                for (int bj = 0; bj < 2; ++bj) { const int n = EPI_COL(bj), i = n >> 4, c0 = n & 15; f32x4 v0 = acc[ai][bj][m][0], v1 = acc[ai][bj][m][1];
#pragma unroll
                    for (int e = 0; e < 4; ++e) { v0[e] = gelu_tanh(v0[e]); v1[e] = gelu_tanh(v1[e]); }
                    *(u32x4*)(Y + (size_t)(row * TCH + i) * 1024 + u.g * 16 + c0) = pack8(v0, v1); } }
    }
};
struct EpiGlu {
    static constexpr bool MID = false;
    const bf16_t* Y; const float* bias; bf16_t* MIX; float* rsq;
    __device__ __forceinline__ void operator()(EPI_ARGS) const {
#pragma unroll
        for (int bj = 0; bj < 2; ++bj) { const int col0 = EPI_COL(bj); const f32x4 b0 = *(const f32x4*)(bias + col0), b1 = *(const f32x4*)(bias + col0 + 4);
#pragma unroll
            for (int ai = 0; ai < 2; ++ai)
#pragma unroll
                for (int m = 0; m < 4; ++m) { const int row = EPI_ROW(ai, m); const u32x4 yv = *(const u32x4*)(Y + (size_t)row * 1024 + col0);
                    f32x4 v0 = acc[ai][bj][m][0] + b0, v1 = acc[ai][bj][m][1] + b1;
                    v0[0] = __uint_as_float(yv.x << 16) * sigmoidf_(v0[0]); v0[1] = __uint_as_float(yv.x & 0xffff0000u) * sigmoidf_(v0[1]);
                    v0[2] = __uint_as_float(yv.y << 16) * sigmoidf_(v0[2]); v0[3] = __uint_as_float(yv.y & 0xffff0000u) * sigmoidf_(v0[3]);
                    v1[0] = __uint_as_float(yv.z << 16) * sigmoidf_(v1[0]); v1[1] = __uint_as_float(yv.z & 0xffff0000u) * sigmoidf_(v1[1]);
                    v1[2] = __uint_as_float(yv.w << 16) * sigmoidf_(v1[2]); v1[3] = __uint_as_float(yv.w & 0xffff0000u) * sigmoidf_(v1[3]);
                    *(u32x4*)(MIX + (size_t)row * 2048 + 1024 + col0) = pack8(v0, v1);
                    float ss = (v0[0] * v0[0] + v0[1] * v0[1]) + (v0[2] * v0[2] + v0[3] * v0[3]) + (v1[0] * v1[0] + v1[1] * v1[1]) + (v1[2] * v1[2] + v1[3] * v1[3]);
                    ss += __shfl_xor(ss, 16); ss += __shfl_xor(ss, 32);
                    if (fq == 0) atomicAdd(rsq + row, ss); } }
    }
};
struct EpiFfn {
    static constexpr bool MID = false;
    bf16_t* H; const float* rsq;
    __device__ __forceinline__ void operator()(EPI_ARGS) const {
        const int col0 = u.pn * 128 + wc * 32 + 8 * fq;
#pragma unroll
        for (int ai = 0; ai < 2; ++ai)
#pragma unroll
            for (int m = 0; m < 4; ++m) { const int row = EPI_ROW(ai, m); const float rs = __builtin_amdgcn_rsqf(rsq[row] * (1.f / DM) + RMS_EPS); f32x4 v0, v1;
                const float c1 = -1.4426950408889634f * rs, rs2 = rs * rs;
                { const f32x4 g = acc[ai][0][m][0], u = acc[ai][1][m][0]; f32x4 t = g * c1, r;
#pragma unroll
                  for (int e = 0; e < 4; ++e) t[e] = __builtin_amdgcn_exp2f(t[e]);
                  t = t + 1.f;
#pragma unroll
                  for (int e = 0; e < 4; ++e) r[e] = __builtin_amdgcn_rcpf(t[e]);
                  v0 = (g * u) * (r * rs2); }
                { const f32x4 g = acc[ai][0][m][1], u = acc[ai][1][m][1]; f32x4 t = g * c1, r;
#pragma unroll
                  for (int e = 0; e < 4; ++e) t[e] = __builtin_amdgcn_exp2f(t[e]);
                  t = t + 1.f;
#pragma unroll
                  for (int e = 0; e < 4; ++e) r[e] = __builtin_amdgcn_rcpf(t[e]);
                  v1 = (g * u) * (r * rs2); }
                *(u32x4*)(H + (size_t)row * DFF + col0) = pack8(v0, v1);
                if (m & 1) asm volatile("" ::: "memory"); }
    }
};

namespace att {
using bf16x8 = __attribute__((ext_vector_type(8))) short;
using s16x4  = __attribute__((ext_vector_type(4))) short;
using f32x16 = __attribute__((ext_vector_type(16))) float;
constexpr int NW = 8, QBLK = 32, KVBLK = 64;
constexpr float SCALE = 0.07216878364870322f;
constexpr float THR = 8.f;
constexpr int LDQ = 1536, LDKV = 2112, LDO = 2048;
constexpr int SHM_V = KVBLK * 128 * 2, SHM_K = KVBLK * QKD * 2, SHM_ATTN = 2 * SHM_V + 3 * SHM_K + NW * 64 * 4 + NW * 4096;
#define KSWZ(row, colB) ((row) * 384 + ((colB) ^ ((((row) >> 1) & 7) << 4)))
#define SBAR() __builtin_amdgcn_sched_barrier(0)
__device__ __forceinline__ int crow(int r, int hi) { return (r & 3) + 8 * (r >> 2) + 4 * hi; }
typedef __bf16 bf16x2_t __attribute__((ext_vector_type(2)));
typedef float f32x2_t __attribute__((ext_vector_type(2)));
__device__ __forceinline__ unsigned cvtpk(float lo, float hi) { const f32x2_t v = {lo, hi}; return __builtin_bit_cast(unsigned, __builtin_convertvector(v, bf16x2_t)); }
__device__ __forceinline__ void partialSM(f32x16& p0, f32x16& p1, float& M, float& alpha) {
  float pmax = p0[0];
#pragma unroll
  for (int r = 1; r < 16; ++r) pmax = fmaxf(pmax, p0[r]);
#pragma unroll
  for (int r = 0; r < 16; ++r) pmax = fmaxf(pmax, p1[r]);
  { auto rr = __builtin_amdgcn_permlane32_swap(__float_as_uint(pmax), __float_as_uint(pmax), false, false);
    pmax = fmaxf(__uint_as_float(rr[0]), __uint_as_float(rr[1])); }
  const float mn = fmaxf(M, pmax);
  alpha = __builtin_amdgcn_exp2f(M - mn); M = mn;
#pragma unroll
  for (int r = 0; r < 16; ++r) { p0[r] -= mn; p1[r] -= mn; }
#pragma unroll
  for (int r = 0; r < 16; ++r) p0[r] = __builtin_amdgcn_exp2f(p0[r]);
}
__device__ __forceinline__ void finishSM(f32x16& p0, f32x16& p1, float alpha, float& l_reg, bf16x8& pa0, bf16x8& pa1, bf16x8& pa2, bf16x8& pa3) {
#pragma unroll
  for (int r = 0; r < 16; ++r) p1[r] = __builtin_amdgcn_exp2f(p1[r]);
  float ps = 0;
#pragma unroll
  for (int r = 0; r < 16; ++r) ps += p0[r];
#pragma unroll
  for (int r = 0; r < 16; ++r) ps += p1[r];
  { auto rr = __builtin_amdgcn_permlane32_swap(__float_as_uint(ps), __float_as_uint(ps), false, false);
    ps = __uint_as_float(rr[0]) + __uint_as_float(rr[1]); }
  l_reg = l_reg * alpha + ps;
#define PK4(P, BASE, OUT) do { unsigned a0 = cvtpk(P[BASE + 0], P[BASE + 1]), a1 = cvtpk(P[BASE + 2], P[BASE + 3]);   \
    unsigned b0 = cvtpk(P[BASE + 4], P[BASE + 5]), b1 = cvtpk(P[BASE + 6], P[BASE + 7]);                              \
    auto r0 = __builtin_amdgcn_permlane32_swap(a0, b0, false, false); auto r1 = __builtin_amdgcn_permlane32_swap(a1, b1, false, false); \
    u32x4 w = {r0[0], r1[0], r0[1], r1[1]}; OUT = *reinterpret_cast<bf16x8*>(&w); } while (0)
  PK4(p0, 0, pa0); PK4(p0, 8, pa1); PK4(p1, 0, pa2); PK4(p1, 8, pa3);
#undef PK4
}
__device__ __forceinline__ void qkt(f32x16& p0, f32x16& p1, const char* Ks, const bf16x8* qr, const char* qlds, const int* kb) {
  p0 = f32x16{}; p1 = f32x16{};
#pragma unroll
  for (int d0 = 0; d0 < 12; ++d0) { const int off = kb[d0 & 3] + (d0 >> 2) * 128;
    bf16x8 b0 = *reinterpret_cast<const bf16x8*>(Ks + off);
    bf16x8 b1 = *reinterpret_cast<const bf16x8*>(Ks + off + 32 * 384);
    bf16x8 q; if (d0 < 8) q = qr[d0]; else q = *reinterpret_cast<const bf16x8*>(qlds + (d0 - 8) * 1024);
    p0 = __builtin_amdgcn_mfma_f32_32x32x16_bf16(b0, q, p0, 0, 0, 0);
    p1 = __builtin_amdgcn_mfma_f32_32x32x16_bf16(b1, q, p1, 0, 0, 0); }
}
__device__ __forceinline__ int v_st(int k, int c) { const int kk = (k & ~0xC) | ((k & 4) << 1) | ((k & 8) >> 1); return ((kk >> 3) * 4 + (c >> 5)) * 512 + ((kk & 7) * 32 + (c & 31)) * 2; }
__device__ __forceinline__ int v_rd_base(int lane) { return ((lane & 3) << 3) | (((lane >> 2) & 3) << 6) | (((lane >> 4) & 1) << 5) | (((lane >> 5) & 1) << 8); }
constexpr int v_rd_off(int d0, int ks, int half) { return d0 * 512 + ks * 4096 + half * 2048; }
typedef __attribute__((address_space(3))) s16x4 lds_s16x4;
template <int OFF> __device__ __forceinline__ s16x4 tr_read(const __attribute__((address_space(3))) char* vb) { return __builtin_amdgcn_ds_read_tr16_b64_v4i16((lds_s16x4*)(vb + OFF)); }
template <int D0> __device__ __forceinline__ void pv_one(f32x16& od, const __attribute__((address_space(3))) char* vb, bf16x8 pa0, bf16x8 pa1, bf16x8 pa2, bf16x8 pa3) {
  const s16x4 l0 = tr_read<v_rd_off(D0, 0, 0)>(vb), h0 = tr_read<v_rd_off(D0, 0, 1)>(vb), l1 = tr_read<v_rd_off(D0, 1, 0)>(vb), h1 = tr_read<v_rd_off(D0, 1, 1)>(vb);
  const s16x4 l2 = tr_read<v_rd_off(D0, 2, 0)>(vb), h2 = tr_read<v_rd_off(D0, 2, 1)>(vb), l3 = tr_read<v_rd_off(D0, 3, 0)>(vb), h3 = tr_read<v_rd_off(D0, 3, 1)>(vb);
#define PK(L, H) (bf16x8){L[0], L[1], L[2], L[3], H[0], H[1], H[2], H[3]}
  od = __builtin_amdgcn_mfma_f32_32x32x16_bf16(pa0, PK(l0, h0), od, 0, 0, 0);
  od = __builtin_amdgcn_mfma_f32_32x32x16_bf16(pa1, PK(l1, h1), od, 0, 0, 0);
  od = __builtin_amdgcn_mfma_f32_32x32x16_bf16(pa2, PK(l2, h2), od, 0, 0, 0);
  od = __builtin_amdgcn_mfma_f32_32x32x16_bf16(pa3, PK(l3, h3), od, 0, 0, 0);
#undef PK
}
__device__ __forceinline__ void pv_d0(f32x16* o, const __attribute__((address_space(3))) char* vb, bf16x8 pa0, bf16x8 pa1, bf16x8 pa2, bf16x8 pa3) {
  pv_one<0>(o[0], vb, pa0, pa1, pa2, pa3); pv_one<1>(o[1], vb, pa0, pa1, pa2, pa3); pv_one<2>(o[2], vb, pa0, pa1, pa2, pa3); pv_one<3>(o[3], vb, pa0, pa1, pa2, pa3);
}
struct SMState { float ps, pmax; };
template <int I> __device__ __forceinline__ void fs_chunk(f32x16& p0, f32x16& p1, float alpha, float& l_reg, SMState& st, bf16x8& pa0, bf16x8& pa1, bf16x8& pa2, bf16x8& pa3) {
#define PK4(P, BASE, OUT) do { unsigned a0 = cvtpk(P[BASE + 0], P[BASE + 1]), a1 = cvtpk(P[BASE + 2], P[BASE + 3]);   \
    unsigned b0 = cvtpk(P[BASE + 4], P[BASE + 5]), b1 = cvtpk(P[BASE + 6], P[BASE + 7]);                              \
    auto r0 = __builtin_amdgcn_permlane32_swap(a0, b0, false, false); auto r1 = __builtin_amdgcn_permlane32_swap(a1, b1, false, false); \
    u32x4 w = {r0[0], r1[0], r0[1], r1[1]}; OUT = *reinterpret_cast<bf16x8*>(&w); } while (0)
  if constexpr (I < 4) {
#pragma unroll
    for (int r = 4 * I; r < 4 * I + 4; ++r) p1[r] = __builtin_amdgcn_exp2f(p1[r]);
    if constexpr (I == 0) st.ps = 0.f;
  } else if constexpr (I < 8) { constexpr int j = 4 * (I - 4);
#pragma unroll
    for (int r = j; r < j + 4; ++r) st.ps += p0[r];
#pragma unroll
    for (int r = j; r < j + 4; ++r) st.ps += p1[r];
  } else if constexpr (I == 8) {
    const float ps_ = st.ps;
    auto rr = __builtin_amdgcn_permlane32_swap(__float_as_uint(ps_), __float_as_uint(ps_), false, false);
    l_reg = l_reg * alpha + (__uint_as_float(rr[0]) + __uint_as_float(rr[1]));
    PK4(p0, 0, pa0);
  } else if constexpr (I == 9) { PK4(p0, 8, pa1); }
  else if constexpr (I == 10) { PK4(p1, 0, pa2); }
  else { PK4(p1, 8, pa3); }
#undef PK4
}
constexpr float THR2 = THR * 1.4426950408889634f;
template <int I> __device__ __forceinline__ void ps_chunk(f32x16& p0, f32x16& p1, float& M, float& alpha, SMState& st) {
  if constexpr (I == 0) { float m = p0[0];
#pragma unroll
    for (int r = 1; r < 16; ++r) m = fmaxf(m, p0[r]);
    st.pmax = m;
  } else if constexpr (I == 1) { float m = st.pmax;
#pragma unroll
    for (int r = 0; r < 16; ++r) m = fmaxf(m, p1[r]);
    auto rr = __builtin_amdgcn_permlane32_swap(__float_as_uint(m), __float_as_uint(m), false, false);
    st.pmax = fmaxf(__uint_as_float(rr[0]), __uint_as_float(rr[1]));
  } else if constexpr (I == 2) {
    alpha = 1.f;
    if (__builtin_expect(!__all(st.pmax <= THR2), 0)) { const float d = fmaxf(st.pmax, 0.f); M += d; alpha = __builtin_amdgcn_exp2f(-d);
#pragma unroll
      for (int r = 0; r < 16; ++r) { p0[r] -= d; p1[r] -= d; } }
#pragma unroll
    for (int r = 0; r < 2; ++r) p0[r] = __builtin_amdgcn_exp2f(p0[r]);
  } else if constexpr (I < 7) { constexpr int lo = 2 + 3 * (I - 3), hi_ = lo + 3;
#pragma unroll
    for (int r = lo; r < hi_; ++r) p0[r] = __builtin_amdgcn_exp2f(p0[r]);
  } else {
#pragma unroll
    for (int r = 14; r < 16; ++r) p0[r] = __builtin_amdgcn_exp2f(p0[r]);
  }
  if constexpr (I >= 2) asm volatile("" : "+v"(p0), "+v"(p1));
}
__device__ __forceinline__ void partialSM0(f32x16& p0, f32x16& p1, float& M) {
  float pmax = p0[0];
#pragma unroll
  for (int r = 1; r < 16; ++r) pmax = fmaxf(pmax, p0[r]);
#pragma unroll
  for (int r = 0; r < 16; ++r) pmax = fmaxf(pmax, p1[r]);
  { auto rr = __builtin_amdgcn_permlane32_swap(__float_as_uint(pmax), __float_as_uint(pmax), false, false);
    pmax = fmaxf(__uint_as_float(rr[0]), __uint_as_float(rr[1])); }
  M = pmax;
#pragma unroll
  for (int r = 0; r < 16; ++r) { p0[r] -= pmax; p1[r] -= pmax; }
#pragma unroll
  for (int r = 0; r < 16; ++r) p0[r] = __builtin_amdgcn_exp2f(p0[r]);
}
template <int D0> __device__ __forceinline__ void kq_load(bf16x8& b0, bf16x8& b1, bf16x8& q, const char* Ks, const bf16x8* qr, const char* qlds, const int* kb) {
  const int off = kb[D0 & 3] + (D0 >> 2) * 128;
  b0 = *reinterpret_cast<const bf16x8*>(Ks + off); b1 = *reinterpret_cast<const bf16x8*>(Ks + off + 32 * 384);
  if constexpr (D0 < 8) q = qr[D0]; else q = *reinterpret_cast<const bf16x8*>(qlds + (D0 - 8) * 1024);
}
struct DmaCtx { unsigned gk, gv; unsigned koff[3], voff[2]; char* kd; char* vd; int wid; __amdgpu_buffer_rsrc_t srd; };
typedef __attribute__((address_space(3))) unsigned lds_u32_t;
template <int P> __device__ __forceinline__ void dma_piece(const DmaCtx& c) {
  if constexpr (P < 3) __builtin_amdgcn_raw_ptr_buffer_load_lds(c.srd, (lds_u32_t*)(c.kd + (c.wid + 8 * P) * 1024), 16, c.koff[P], c.gk, 0, 0);
  else __builtin_amdgcn_raw_ptr_buffer_load_lds(c.srd, (lds_u32_t*)(c.vd + (c.wid + 8 * (P - 3)) * 1024), 16, c.voff[P - 3], c.gv, 0, 0);
}
template <int D0> __device__ __forceinline__ void h1_stage(f32x16& pc0, f32x16& pc1, f32x16& pp0, f32x16& pp1, float alP, float& l_reg, SMState& st, bf16x8& pa0, bf16x8& pa1, bf16x8& pa2, bf16x8& pa3,
                                                           bf16x8 b0, bf16x8 b1, bf16x8 q, bf16x8 n0, bf16x8 n1, bf16x8 nq, const char* Ks, const bf16x8* qr, const char* qlds, const int* kb, const DmaCtx& dc) {
  bf16x8 m0, m1, mq;
  if constexpr (D0 < 10) kq_load<D0 + 2>(m0, m1, mq, Ks, qr, qlds, kb);
  pc0 = __builtin_amdgcn_mfma_f32_32x32x16_bf16(b0, q, pc0, 0, 0, 0);
  pc1 = __builtin_amdgcn_mfma_f32_32x32x16_bf16(b1, q, pc1, 0, 0, 0);
  if constexpr (D0 >= 1 && D0 <= 5) dma_piece<D0 - 1>(dc);
  SBAR(); fs_chunk<D0>(pp0, pp1, alP, l_reg, st, pa0, pa1, pa2, pa3); SBAR();
  if constexpr (D0 < 11) h1_stage<D0 + 1>(pc0, pc1, pp0, pp1, alP, l_reg, st, pa0, pa1, pa2, pa3, n0, n1, nq, m0, m1, mq, Ks, qr, qlds, kb, dc);
}
typedef __attribute__((address_space(3))) s16x4 lds_s16x4b;
template <int G> __device__ __forceinline__ void v_load(s16x4& la, s16x4& ha, s16x4& lb, s16x4& hb, const __attribute__((address_space(3))) char* vb) {
  constexpr int ks = G >> 1, d0 = (G & 1) * 2;
  la = __builtin_amdgcn_ds_read_tr16_b64_v4i16((lds_s16x4b*)(vb + v_rd_off(d0, ks, 0))); ha = __builtin_amdgcn_ds_read_tr16_b64_v4i16((lds_s16x4b*)(vb + v_rd_off(d0, ks, 1)));
  lb = __builtin_amdgcn_ds_read_tr16_b64_v4i16((lds_s16x4b*)(vb + v_rd_off(d0 + 1, ks, 0))); hb = __builtin_amdgcn_ds_read_tr16_b64_v4i16((lds_s16x4b*)(vb + v_rd_off(d0 + 1, ks, 1)));
}
template <int G> __device__ __forceinline__ void h2_stage(f32x16* o, f32x16& pc0, f32x16& pc1, float& m_reg, float& alC, SMState& st, bf16x8 pa0, bf16x8 pa1, bf16x8 pa2, bf16x8 pa3,
                                                          s16x4 la, s16x4 ha, s16x4 lb, s16x4 hb, const __attribute__((address_space(3))) char* vb) {
  constexpr int ks = G >> 1, d0 = (G & 1) * 2;
  s16x4 nla, nha, nlb, nhb;
  if constexpr (G < 7) v_load<G + 1>(nla, nha, nlb, nhb, vb);
  const bf16x8 pa = ks == 0 ? pa0 : ks == 1 ? pa1 : ks == 2 ? pa2 : pa3;
#define PK(L, H) (bf16x8){L[0], L[1], L[2], L[3], H[0], H[1], H[2], H[3]}
  o[d0] = __builtin_amdgcn_mfma_f32_32x32x16_bf16(pa, PK(la, ha), o[d0], 0, 0, 0);
  o[d0 + 1] = __builtin_amdgcn_mfma_f32_32x32x16_bf16(pa, PK(lb, hb), o[d0 + 1], 0, 0, 0);
#undef PK
  SBAR(); ps_chunk<G>(pc0, pc1, m_reg, alC, st); SBAR();
  if constexpr (G < 7) h2_stage<G + 1>(o, pc0, pc1, m_reg, alC, st, pa0, pa1, pa2, pa3, nla, nha, nlb, nhb, vb);
}
__device__ __forceinline__ void attn_body(const bf16_t* __restrict__ Qb, const bf16_t* __restrict__ KVb, int hcol, bf16_t* __restrict__ Ob, float* __restrict__ rsqa, int seq, char* lds) {
  int tid_ = threadIdx.x; asm volatile("" : "+v"(tid_));
  const int tid = tid_, wid = __builtin_amdgcn_readfirstlane(tid >> 6), lane = tid & 63, r32 = lane & 31, hi = lane >> 5;
  char* V_lds = lds; char* K_lds = lds + 2 * SHM_V;
  float* ws = (float*)(lds + 2 * SHM_V + 3 * SHM_K) + wid * 64; float* li_l = ws; float* al_l = ws + 32;
  float m_reg = -1e30f, l_reg = 0; f32x16 o[4] = {}; bf16x8 qr[8];
  char* qlds = lds + 2 * SHM_V + 3 * SHM_K + NW * 64 * 4 + wid * 4096 + lane * 16;
  int kb[4];
#pragma unroll
  for (int dl = 0; dl < 4; ++dl) kb[dl] = r32 * 384 + ((dl * 32 + hi * 16) ^ (((r32 >> 1) & 7) << 4));
  const bf16_t* Qw = Qb + (long)(wid * QBLK + r32) * LDQ + hi * 8;
#pragma unroll
  for (int d0 = 0; d0 < 8; ++d0) qr[d0] = *reinterpret_cast<const bf16x8*>(Qw + d0 * 16);
#pragma unroll
  for (int d0 = 8; d0 < 12; ++d0) *reinterpret_cast<bf16x8*>(qlds + (d0 - 8) * 1024) = *reinterpret_cast<const bf16x8*>(Qw + d0 * 16);
  DmaCtx dc; dc.wid = wid; dc.srd = __builtin_amdgcn_make_buffer_rsrc((void*)KVb, (short)0, 0x7fffffff, 0x00020000);
#pragma unroll
  for (int i = 0; i < 3; ++i) { const int b = (wid + 8 * i) * 1024 + lane * 16, row = b / 384, x = b % 384, blk = x >> 7, ch = ((x & 127) >> 4) ^ ((row >> 1) & 7), col = blk * 64 + ch * 8;
    dc.koff[i] = (unsigned)(row * LDKV + (col < 128 ? hcol + col : 2048 + (col - 128))) * 2u; }
#pragma unroll
  for (int i = 0; i < 2; ++i) { const int b = (wid + 8 * i) * 1024 + lane * 16, st_ = b >> 9, kk = (st_ >> 2) * 8 + ((b & 511) >> 6), c = (st_ & 3) * 32 + ((b & 63) >> 1);
    const int k = (kk & ~0xC) | ((kk & 4) << 1) | ((kk & 8) >> 1);
    dc.voff[i] = (unsigned)(k * LDKV + hcol + 128 + c) * 2u; }
  const __attribute__((address_space(3))) char* vb0 = (const __attribute__((address_space(3))) char*)V_lds + v_rd_base(lane);
  constexpr size_t TILEB = (size_t)KVBLK * LDKV * 2;
#define DMAK(t, s) do { dc.gk = (unsigned)((size_t)(t) * TILEB); dc.kd = K_lds + (s) * SHM_K; dma_piece<0>(dc); dma_piece<1>(dc); dma_piece<2>(dc); } while (0)
#define DMAV(t, s) do { dc.gv = (unsigned)((size_t)(t) * TILEB); dc.vd = V_lds + (s) * SHM_V; dma_piece<3>(dc); dma_piece<4>(dc); } while (0)
#define BAR() do { asm volatile("s_waitcnt lgkmcnt(0)" ::: "memory"); __builtin_amdgcn_s_barrier(); asm volatile("" ::: "memory"); } while (0)
#define NEXT3(s) ((s) == 2 ? 0 : (s) + 1)
#define RESC(a) do { if (__any((a) < 1.f)) { if (hi == 0) al_l[r32] = (a); asm volatile("s_waitcnt lgkmcnt(0)" ::: "memory"); \
    _Pragma("unroll") for (int d = 0; d < 4; ++d) _Pragma("unroll") for (int r = 0; r < 16; ++r) o[d][r] *= al_l[crow(r, hi)]; } } while (0)
#define STEP(PC0, PC1, alC, PP0, PP1, alP, t, sc_, VB) do { \
    SBAR(); { const float nm_ = -m_reg; _Pragma("unroll") for (int r_ = 0; r_ < 16; ++r_) { PC0[r_] = nm_; PC1[r_] = nm_; } } \
    dc.gk = (unsigned)((size_t)((t) + 1) * TILEB); dc.kd = K_lds + NEXT3(sc_) * SHM_K; dc.gv = (unsigned)((size_t)(t) * TILEB); dc.vd = V_lds + (1 - (VB)) * SHM_V; \
    { bf16x8 b0_, b1_, q_, n0_, n1_, nq_; const char* Ks_ = K_lds + (sc_) * SHM_K; kq_load<0>(b0_, b1_, q_, Ks_, qr, qlds, kb); kq_load<1>(n0_, n1_, nq_, Ks_, qr, qlds, kb); \
      h1_stage<0>(PC0, PC1, PP0, PP1, alP, l_reg, st, pa0, pa1, pa2, pa3, b0_, b1_, q_, n0_, n1_, nq_, Ks_, qr, qlds, kb, dc); } \
    { s16x4 la_, ha_, lb_, hb_; const __attribute__((address_space(3))) char* vb_ = vb0 + (VB) * SHM_V; v_load<0>(la_, ha_, lb_, hb_, vb_); \
      h2_stage<0>(o, PC0, PC1, m_reg, alC, st, pa0, pa1, pa2, pa3, la_, ha_, lb_, hb_, vb_); } \
    SBAR(); \
    asm volatile("s_waitcnt vmcnt(0)" ::: "memory");     \
    RESC(alC); BAR();                                     \
    } while (0)
  f32x16 pA0, pA1, pB0, pB1; float alA, alB; bf16x8 pa0, pa1, pa2, pa3; SMState st; const int NT = seq / KVBLK;
  DMAK(0, 0); DMAV(0, 0); DMAK(1, 1);
  asm volatile("s_waitcnt vmcnt(3)" ::: "memory"); BAR();
  qkt(pA0, pA1, K_lds, qr, qlds, kb); partialSM0(pA0, pA1, m_reg); alA = 1.f;
  asm volatile("s_waitcnt vmcnt(0)" ::: "memory"); BAR();
  int sc = 1;
  for (int j = 1; j + 1 < NT; j += 2) {
    STEP(pB0, pB1, alB, pA0, pA1, alA, j, sc, 0);
    sc = NEXT3(sc);
    STEP(pA0, pA1, alA, pB0, pB1, alB, j + 1, sc, 1);
    sc = NEXT3(sc);
  }
  DMAV(NT - 1, 1);
  SBAR(); qkt(pB0, pB1, K_lds + sc * SHM_K, qr, qlds, kb);
  finishSM(pA0, pA1, alA, l_reg, pa0, pa1, pa2, pa3);
  pv_d0(o, vb0, pa0, pa1, pa2, pa3); partialSM(pB0, pB1, m_reg, alB);
  SBAR(); asm volatile("s_waitcnt vmcnt(0)" ::: "memory"); RESC(alB); BAR();
  finishSM(pB0, pB1, alB, l_reg, pa0, pa1, pa2, pa3);
  pv_d0(o, vb0 + SHM_V, pa0, pa1, pa2, pa3);
  if (hi == 0) li_l[r32] = l_reg; asm volatile("s_waitcnt lgkmcnt(0)" ::: "memory");
  float rli[16];
#pragma unroll
  for (int r = 0; r < 16; ++r) rli[r] = __builtin_amdgcn_rcpf(li_l[crow(r, hi)]);
  bf16_t* Ow = Ob + (long)(wid * QBLK) * LDO;
#pragma unroll
  for (int r = 0; r < 16; ++r) { int orow = crow(r, hi); float sq = 0.f;
#pragma unroll
    for (int d0 = 0; d0 < 4; ++d0) { const float v = o[d0][r] * rli[r]; sq += v * v; Ow[(long)orow * LDO + d0 * 32 + r32] = (bf16_t)(cvtpk(v, 0.f) & 0xffffu); }
    sq += __shfl_xor(sq, 1); sq += __shfl_xor(sq, 2); sq += __shfl_xor(sq, 4); sq += __shfl_xor(sq, 8); sq += __shfl_xor(sq, 16);
    if (r32 == 0) atomicAdd(rsqa + wid * QBLK + orow, sq); }
#undef DMAK
#undef DMAV
#undef BAR
#undef NEXT3
#undef RESC
#undef STEP
}
}

constexpr size_t MiB = 1u << 20;
constexpr size_t WS_RSQQ = 0, WS_RSQKV = 128 * 1024, WS_BAR = 256 * 1024, BAR_BYTES = 16 * 1024, WS_RSQA = 384 * 1024, WS_RSQS = 512 * 1024, WS_RSQX = 640 * 1024;
constexpr size_t WS_ROPE = 1 * MiB, WS_KT = 5 * MiB;
constexpr size_t WS_WGU = 10 * MiB, WS_WDOWN = 54 * MiB, WS_WIN = 76 * MiB, WS_WQB = 84 * MiB, WS_WKVB = 86 * MiB, WS_WGLU = 87 * MiB, WS_WOUT = 89 * MiB;
constexpr size_t WS_KW = 97 * MiB, WS_WST = 145 * MiB;
constexpr size_t WS_XN = 161 * MiB, WS_KV = 161 * MiB, WS_MB = 161 * MiB;
constexpr size_t WS_CQ = 260 * MiB, WS_CKV = 284 * MiB, WS_UG = 299 * MiB, WS_MIX = 260 * MiB;
constexpr size_t WS_Q = 371 * MiB, WS_SBUF = 443 * MiB, WS_Y = 443 * MiB, WS_KR = 491 * MiB;
constexpr size_t WS_H = 416 * MiB, WS_F = 416 * MiB, WS_HMID = 76 * MiB, WS_END = 512 * MiB;

constexpr int LDS_BYTES = 147456;
#ifndef PH_MASK
#define PH_MASK 0xFFF
#endif
#ifndef ATT_REP
#define ATT_REP 1
#endif
#ifndef FFN_REP
#define FFN_REP 1
#endif
#define PH_ON(k) if constexpr (((PH_MASK) >> (k)) & 1)

struct Params {
    const float* in[27]; float* out; unsigned char* ws;
};

__device__ __forceinline__ float wave_sum(float v) {
#pragma unroll
    for (int o = 1; o < 64; o <<= 1) v += __shfl_xor(v, o);
    return v;
}
typedef __bf16 bf16x2_h __attribute__((ext_vector_type(2)));
typedef float f32x2_h __attribute__((ext_vector_type(2)));
__device__ __forceinline__ unsigned pk2(float lo, float hi) { const f32x2_h v = {lo, hi}; return __builtin_bit_cast(unsigned, __builtin_convertvector(v, bf16x2_h)); }
__device__ __forceinline__ unsigned f2bf(float f) { return pk2(f, 0.f) & 0xffffu; }
__device__ __forceinline__ int il64(int r) { return r < 32 ? 2 * r : 2 * (r - 32) + 1; }
__device__ __forceinline__ int map_row(int mode, int n) {
    switch (mode) {
        case 1: return n < 768 ? n : (n < 832 ? 1792 + il64(n - 768) : 768 + (n - 832));
        case 2: { const int h = n / 192, d = n % 192; return d < 128 ? n : h * 192 + 128 + il64(d - 128); }
        case 3: return (n >> 7) * 256 + (n & 127);
        case 4: return (n >> 7) * 256 + 128 + (n & 127);
        default: return n;
    }
}
__device__ __forceinline__ void transpose_item(const float* W, int K, int N, bf16_t* WT, int mode, const float* gain, LASP float* scr, int item, int lane) {
    const int nblk = N / 32, kb = item / nblk, nb = item % nblk, k0 = 64 * kb, n0 = 32 * nb;
    float tv[32];
#pragma unroll
    for (int i = 0; i < 32; ++i) tv[i] = W[(size_t)(k0 + 2 * i + (lane >> 5)) * N + n0 + (lane & 31)];
    if (gain) {
#pragma unroll
        for (int i = 0; i < 32; ++i) tv[i] *= gain[k0 + 2 * i + (lane >> 5)]; }
#pragma unroll
    for (int i = 0; i < 32; ++i) scr[(2 * i + (lane >> 5)) * 33 + (lane & 31)] = tv[i];
    asm volatile("s_waitcnt lgkmcnt(0)" ::: "memory");
    const int c = lane & 7;
#pragma unroll
    for (int j = 0; j < 4; ++j) { const int n = (lane >> 3) + 8 * j; const LASP float* s = scr + (8 * c) * 33 + n;
        u32x4 o; o.x = pk2(s[0 * 33], s[1 * 33]); o.y = pk2(s[2 * 33], s[3 * 33]); o.z = pk2(s[4 * 33], s[5 * 33]); o.w = pk2(s[6 * 33], s[7 * 33]);
        *(u32x4*)(WT + (size_t)map_row(mode, n0 + n) * K + k0 + 8 * c) = o; }
    asm volatile("s_waitcnt lgkmcnt(0)" ::: "memory");
}
__device__ __forceinline__ const float* xrow_ptr(const Params& p, int row) { return row < MPROMPT ? p.in[0] + (size_t)row * DM : p.in[1] + (size_t)(row - MPROMPT) * DM; }

struct cf { float re, im; };
__device__ __forceinline__ cf cmul(cf a, cf b) { return cf{a.re * b.re - a.im * b.im, a.re * b.im + a.im * b.re}; }
__device__ __forceinline__ cf lam_pow(float a, float brev, float e) {
    const float mag = __expf(e * a); float rev = e * brev; rev -= __builtin_rintf(rev);
    return cf{mag * __builtin_amdgcn_cosf(rev), mag * __builtin_amdgcn_sinf(rev)};
}
__device__ __forceinline__ cf zoh_coef(float lre, float lim, float dt) {
    const float a = lre * dt, b = lim * dt, brev = b * 0.15915494309189535f;
    const float em1 = expm1f(a), ea = em1 + 1.f, cb = __builtin_amdgcn_cosf(brev), sb = __builtin_amdgcn_sinf(brev), sh = __builtin_amdgcn_sinf(0.5f * brev);
    const float nr = em1 * cb - 2.f * sh * sh, ni = ea * sb;
    const float den = 1.f / (lre * lre + lim * lim);
    return cf{(nr * lre + ni * lim) * den, (ni * lre - nr * lim) * den};
}

#define XB_TMO      128
#define XB_XCNT(j)  (256  + 64 * (j))
#define XB_XSUB(j)  (1280 + 64 * (j))
#define XB_XGEN(j)  (2304 + 64 * (j))
#define XB_TOP      3328
#define XB_TOPGEN   3392
#define XCD_BAR_WORDS 3456
#define XB_SPIN_CAP (1u << 18)

__device__ __forceinline__ unsigned xb_ld(unsigned* p)              { return __hip_atomic_load(p, __ATOMIC_RELAXED, __HIP_MEMORY_SCOPE_AGENT); }
__device__ __forceinline__ unsigned xb_add(unsigned* p, unsigned v) { return __hip_atomic_fetch_add(p, v, __ATOMIC_RELAXED, __HIP_MEMORY_SCOPE_AGENT); }
__device__ __forceinline__ unsigned xb_xcc_id() { return (unsigned)__builtin_amdgcn_s_getreg((3 << 11) | 20) & 0xFu; }
#define XB_SPIN(cond, bar) do { unsigned _sp = 0; while (cond) { __builtin_amdgcn_s_sleep(1); \
    if ((++_sp & 255u) == 0u) { if (xb_ld(&(bar)[XB_TMO])) break; if (_sp > XB_SPIN_CAP) { atomicAdd(&(bar)[XB_TMO], 1u); break; } } } } while (0)

struct XcdBarrier {
    unsigned* bar; unsigned x;
    volatile LASP unsigned* st;
};

__device__ __forceinline__ XcdBarrier xcd_barrier_post(unsigned* bar, volatile LASP unsigned* st) {
    XcdBarrier b; b.bar = bar; b.x = xb_xcc_id(); b.st = st;
    if (threadIdx.x == 0) (void)xb_add(&bar[XB_XCNT(b.x)], 1u);
    return b;
}
__device__ __forceinline__ void xcd_barrier_complete(unsigned* bar, unsigned x, unsigned& nloc, unsigned& nx) {
    const unsigned G = gridDim.x * gridDim.y * gridDim.z;
    unsigned sum, cnt, mine, sp = 0u;
    for (;;) {
        sum = 0u; cnt = 0u; mine = 0u;
#pragma unroll
        for (unsigned j = 0; j < 16; ++j) { const unsigned c = xb_ld(&bar[XB_XCNT(j)]); sum += c; cnt += (c > 0u) ? 1u : 0u; mine = (j == x) ? c : mine; }
        if (sum == G) break;
        __builtin_amdgcn_s_sleep(1);
        if ((++sp & 255u) == 0u) { if (xb_ld(&bar[XB_TMO])) break; if (sp > XB_SPIN_CAP) { atomicAdd(&bar[XB_TMO], 1u); break; } }
    }
    nloc = mine > 0u ? mine : 1u; nx = cnt > 0u ? cnt : 1u;
}

__device__ __forceinline__ void xcd_barrier(const XcdBarrier& b) {
    asm volatile("s_waitcnt vmcnt(0)" ::: "memory");
    __syncthreads();
    if (threadIdx.x == 0) {
        unsigned* bar = b.bar;
        __builtin_amdgcn_s_waitcnt(0);
        unsigned nloc = b.st[0], nx = b.st[1];
        if (nloc == 0u) { xcd_barrier_complete(bar, b.x, nloc, nx); b.st[0] = nloc; b.st[1] = nx; }
        const unsigned old = xb_add(&bar[XB_XSUB(b.x)], 1u);
        const unsigned gen = old / nloc;
        if (old + 1u == (gen + 1u) * nloc) {
            __builtin_amdgcn_fence(__ATOMIC_RELEASE, "agent");
            asm volatile("s_waitcnt vmcnt(0)" ::: "memory");
            const unsigned og = xb_add(&bar[XB_TOP], 1u);
            const unsigned tg = og / nx;
            if (og + 1u == (tg + 1u) * nx) xb_add(&bar[XB_TOPGEN], 1u);
            else XB_SPIN(xb_ld(&bar[XB_TOPGEN]) == tg, bar);
            __builtin_amdgcn_fence(__ATOMIC_ACQUIRE, "agent");
            xb_add(&bar[XB_XGEN(b.x)], 1u);
            asm volatile("s_waitcnt vmcnt(0)" ::: "memory");
        } else {
            XB_SPIN(xb_ld(&bar[XB_XGEN(b.x)]) == gen, bar);
            __builtin_amdgcn_fence(__ATOMIC_ACQUIRE, "agent");
            asm volatile("s_waitcnt vmcnt(0)" ::: "memory");
        }
    }
    __syncthreads();
}


__device__ __forceinline__ void ffn_weight_items(const Params& p, unsigned char* ws, LASP unsigned char* ldsl, int lo, int hi, int bid, int wave, int lane) {
    constexpr int I_G = (DM / 64) * (DFF / 32);
    LASP float* scr = (LASP float*)(ldsl + wave * 16384);
    for (int it = lo + (bid - 128) * 8 + wave; it < hi; it += 128 * 8) {
        int r = it;
        if (r < I_G) { transpose_item(p.in[23], DM, DFF, (bf16_t*)(ws + WS_WGU), 3, p.in[22], scr, r, lane); continue; } r -= I_G;
        if (r < I_G) { transpose_item(p.in[24], DM, DFF, (bf16_t*)(ws + WS_WGU), 4, p.in[22], scr, r, lane); continue; } r -= I_G;
        transpose_item(p.in[25], DFF, DM, (bf16_t*)(ws + WS_WDOWN), 0, nullptr, scr, r, lane);
    }
}
template <int SEG>
__device__ __forceinline__ void scan_item(const Params& p, unsigned char* ws, LASP float* E, int s, int g, int dir, int wave, int lane) {
    const int nch = 8 * SEG, ch0 = s == 2 ? 256 : s * 128;
    const float dt = __expf(p.in[10][dir * NG + g]); const int li = (dir * NG + g) * 64 + lane;
    const float a = p.in[8][li] * dt, brev = p.in[9][li] * dt * 0.15915494309189535f;
    const cf lT = lam_pow(a, brev, (float)TCH), lTS = lam_pow(a, brev, (float)(TCH * SEG));
    const float* sb = (const float*)(ws + WS_SBUF) + ((size_t)g * NCHUNK + ch0) * 256 + dir * 128 + lane;
    bf16_t* cb = (bf16_t*)(ws + WS_UG) + ((size_t)g * NCHUNK + ch0) * 768 + 512 + dir * 128 + lane;
    const int k0 = dir == 0 ? wave * SEG : nch - 1 - wave * SEG;
    const long stS = dir == 0 ? 256 : -256, stC = dir == 0 ? 768 : -768;
    const float* ps = sb + (long)k0 * 256; bf16_t* pc = cb + (long)k0 * 768;
    cf x{0.f, 0.f};
#pragma unroll 1
    for (int b0 = 0; b0 < SEG; b0 += 16) {
        float sre[16], sim[16];
#pragma unroll
        for (int e = 0; e < 16; ++e) { sre[e] = ps[0]; sim[e] = ps[64]; ps += stS; }
#pragma unroll
        for (int e = 0; e < 16; ++e) { const cf nx = cmul(lT, x); x.re = nx.re + sre[e]; x.im = nx.im + sim[e]; }
    }
    E[(wave * 64 + lane) * 2] = x.re; E[(wave * 64 + lane) * 2 + 1] = x.im;
    __syncthreads();
    cf c{0.f, 0.f};
    for (int v = 0; v < wave; ++v) { const cf nx = cmul(lTS, c); c.re = nx.re + E[(v * 64 + lane) * 2]; c.im = nx.im + E[(v * 64 + lane) * 2 + 1]; }
    x = c; ps = sb + (long)k0 * 256;
#pragma unroll 1
    for (int b0 = 0; b0 < SEG; b0 += 16) {
        float sre[16], sim[16];
#pragma unroll
        for (int e = 0; e < 16; ++e) { sre[e] = ps[0]; sim[e] = ps[64]; ps += stS; }
#pragma unroll
        for (int e = 0; e < 16; ++e) {
            pc[0] = (bf16_t)f2bf(x.re); pc[64] = (bf16_t)f2bf(x.im); pc += stC;
            const cf nx = cmul(lT, x); x.re = nx.re + sre[e]; x.im = nx.im + sim[e]; }
    }
}
#define rsq_q ((float*)(ws + WS_RSQQ))
#define rsq_kv ((float*)(ws + WS_RSQKV))
#define rsq_a ((float*)(ws + WS_RSQA))
#define rsq_s ((float*)(ws + WS_RSQS))
#define rsq_x ((float*)(ws + WS_RSQX))
#define ROPE ((float*)(ws + WS_ROPE))
#define KT ((float*)(ws + WS_KT))
#define Wgu ((bf16_t*)(ws + WS_WGU))
#define Wdown ((bf16_t*)(ws + WS_WDOWN))
#define Win ((bf16_t*)(ws + WS_WIN))
#define Wqb ((bf16_t*)(ws + WS_WQB))
#define Wkvb ((bf16_t*)(ws + WS_WKVB))
#define Wglu ((bf16_t*)(ws + WS_WGLU))
#define Wout ((bf16_t*)(ws + WS_WOUT))
#define KW ((bf16_t*)(ws + WS_KW))
#define Wst ((bf16_t*)(ws + WS_WST))
#define XN ((bf16_t*)(ws + WS_XN))
#define KV ((bf16_t*)(ws + WS_KV))
#define KRB ((bf16_t*)(ws + WS_KR))
#define MB ((bf16_t*)(ws + WS_MB))
#define CQ ((bf16_t*)(ws + WS_CQ))
#define CKV ((bf16_t*)(ws + WS_CKV))
#define UG ((bf16_t*)(ws + WS_UG))
#define MIX ((bf16_t*)(ws + WS_MIX))
#define QBUF ((bf16_t*)(ws + WS_Q))
#define SBUF ((float*)(ws + WS_SBUF))
#define Yb ((bf16_t*)(ws + WS_Y))
#define Hb ((bf16_t*)(ws + WS_H))
#define Fb ((bf16_t*)(ws + WS_F))
#define HMID ((bf16_t*)(ws + WS_HMID))
#define lam_re (p.in[8])
#define lam_im (p.in[9])
#define log_dt (p.in[10])
#define b_re (p.in[11])
#define b_im (p.in[12])
#define c_re (p.in[13])
#define c_im (p.in[14])
#define ssm_d (p.in[15])
__global__ void __launch_bounds__(512, 2) fwd_megakernel(Params p) {
    extern __shared__ __attribute__((aligned(16))) unsigned char lds[];
    cg::grid_group grid = cg::this_grid();
    const int tid = threadIdx.x, lane = tid & 63, wave = __builtin_amdgcn_readfirstlane(tid >> 6);
    const int G = gridDim.x, bid = blockIdx.x;
    const int gw = bid * 8 + wave, NGW = G * 8, gt = bid * 512 + tid, NGT = G * 512;
    unsigned char* ws = p.ws;
    LASP unsigned char* ldsl = (LASP unsigned char*)lds;
    volatile LASP unsigned* bst = (volatile LASP unsigned*)(ldsl + LDS_BYTES - 16);
    if (tid < 4) bst[tid] = 0u;
    __syncthreads();
    const XcdBarrier xbar = xcd_barrier_post((unsigned*)(ws + WS_BAR), bst);

    PH_ON(0) {
        for (int i = gt; i < MROWS; i += NGT) { rsq_q[i] = 0.f; rsq_kv[i] = 0.f; rsq_a[i] = 0.f; rsq_s[i] = 0.f; }
        for (int i = gt; i < LS * 32; i += NGT) { const int pos = i >> 5, j = i & 31;
            const float inv = __builtin_amdgcn_exp2f(-(float)j * (13.287712379549449f / 32.f));
            const float ang = (float)pos * inv; const double rv = (double)ang * 0.15915494309189535; const float fr = (float)(rv - __builtin_rint(rv));
            ROPE[2 * i] = __builtin_amdgcn_cosf(fr); ROPE[2 * i + 1] = __builtin_amdgcn_sinf(fr); }
        for (int i = gt; i < 192 * DM / 8; i += NGT) *(u32x4*)(Win + (size_t)1856 * DM + (size_t)i * 8) = (u32x4){0u, 0u, 0u, 0u};
        LASP float* scr = (LASP float*)(ldsl + wave * 16384);
        constexpr int I_IN = (DM / 64) * (1856 / 32), I_QB = (512 / 64) * (1536 / 32), I_KVB = (256 / 64) * (2048 / 32), I_GLU = (1024 / 64) * (1024 / 32), I_OUT = (DM / 64) * (DM / 32);
        constexpr int I_G = (DM / 64) * (DFF / 32), I_D = (DFF / 64) * (DM / 32);
        constexpr int NITEMS = I_IN + I_QB + I_KVB + I_GLU + I_OUT;
        for (int it = gw; it < NITEMS; it += NGW) {
            int r = it;
            if (r < I_IN) { transpose_item(p.in[3], DM, 1856, Win, 1, nullptr, scr, r, lane); continue; } r -= I_IN;
            if (r < I_QB) { transpose_item(p.in[5], 512, 1536, Wqb, 2, p.in[4], scr, r, lane); continue; } r -= I_QB;
            if (r < I_KVB) { transpose_item(p.in[7], 256, 2048, Wkvb, 0, p.in[6], scr, r, lane); continue; } r -= I_KVB;
            if (r < I_GLU) { transpose_item(p.in[16], 1024, 1024, Wglu, 0, nullptr, scr, r, lane); continue; } r -= I_GLU;
            transpose_item(p.in[20], DM, DM, Wout, 0, (64 * (r / (DM / 32))) < 1024 ? p.in[18] : p.in[19] - 1024, scr, r, lane);
        }
        {
            const float* gpm = p.in[2];
            f32x4 gv[8];
#pragma unroll
            for (int j = 0; j < 8; ++j) gv[j] = *(const f32x4*)(gpm + 4 * lane + 256 * j);
            f32x4 v[8], nv[8];
            { const f32x4* xr = (const f32x4*)xrow_ptr(p, gw) + lane;
#pragma unroll
              for (int j = 0; j < 8; ++j) nv[j] = xr[64 * j]; }
            for (int m = gw; m < MROWS; m += NGW) {
                float s = 0.f;
#pragma unroll
                for (int j = 0; j < 8; ++j) { v[j] = nv[j]; s += (v[j].x * v[j].x + v[j].y * v[j].y) + (v[j].z * v[j].z + v[j].w * v[j].w); }
                if (m + NGW < MROWS) { const f32x4* xr = (const f32x4*)xrow_ptr(p, m + NGW) + lane;
#pragma unroll
                  for (int j = 0; j < 8; ++j) nv[j] = xr[64 * j]; }
                const float rstd = 1.f / sqrtf(wave_sum(s) * (1.f / DM) + RMS_EPS);
                u32x2* o8 = (u32x2*)(XN + (size_t)m * DM) + lane;
#pragma unroll
                for (int j = 0; j < 8; ++j) { const f32x4 w = v[j] * rstd * gv[j]; u32x2 o; o.x = pk2(w.x, w.y); o.y = pk2(w.z, w.w); o8[64 * j] = o; }
            }
        }
        for (int wi = wave * G + bid; wi < 2048 + 2048; wi += 8 * G) {
            if (wi < 2048) {
                const int i = wi * 64 + lane;
                const int ps = i & 3, cc = (i >> 2) & 15, c = (i >> 6) & 15, dir = (i >> 10) & 1, g = i >> 11;
                const float dt = __expf(log_dt[dir * NG + g]);
                float accd[TCH];
#pragma unroll
                for (int d = 0; d < TCH; ++d) accd[d] = 0.f;
#pragma unroll 4
                for (int pq = 0; pq < 16; ++pq) {
                    const int pp = ps * 16 + pq;
                    const int li = (dir * NG + g) * 64 + pp; const float lre = lam_re[li], lim = lam_im[li];
                    const cf coef = zoh_coef(lre, lim, dt);
                    const cf bt = cmul(coef, cf{b_re[(size_t)li * 16 + cc], b_im[(size_t)li * 16 + cc]});
                    const size_t ci = ((size_t)(dir * NG + g) * 16 + c) * 64 + pp;
                    cf z = cmul(cf{c_re[ci], c_im[ci]}, bt);
                    const cf lb = lam_pow(lre * dt, lim * dt * 0.15915494309189535f, 1.f);
#pragma unroll
                    for (int d = 0; d < TCH; ++d) { accd[d] += z.re; z = cmul(z, lb); }
                }
#pragma unroll
                for (int d = 0; d < TCH; ++d) { float v = accd[d]; v += __shfl_xor(v, 1); v += __shfl_xor(v, 2); accd[d] = v; }
                if (ps == 0) {
#pragma unroll
                    for (int d = 0; d < TCH; ++d) KT[(((size_t)(g * 2 + dir) * TCH + d) * 16 + c) * 16 + cc] = accd[d];
                }
            } else {
                const int sub = (wi - 2048) >> 10, jq = (wi - 2048) & 7, i = (((wi - 2048) & 1023) >> 3) * 64 + lane;
                const int pp = i & 63, dir = (i >> 6) & 1, g = i >> 7;
                const float dt = __expf(log_dt[dir * NG + g]);
                const int li = (dir * NG + g) * 64 + pp; const float lre = lam_re[li], lim = lam_im[li];
                const float a = lre * dt, brev = lim * dt * 0.15915494309189535f;
                if (sub == 0) {
                    const cf coef = zoh_coef(lre, lim, dt);
                    bf16_t* wre = Wst + ((size_t)g * 256 + dir * 128 + pp) * 512; bf16_t* wim = wre + 64 * 512;
                    cf bt[16];
#pragma unroll
                    for (int cc = 0; cc < 16; ++cc) bt[cc] = cmul(coef, cf{b_re[(size_t)li * 16 + cc], b_im[(size_t)li * 16 + cc]});
                    for (int j = 4 * jq; j < 4 * jq + 4; ++j) {
                        const cf lp = lam_pow(a, brev, dir == 0 ? (float)(TCH - 1 - j) : (float)j);
                        float vr[16], vi[16];
#pragma unroll
                        for (int cc = 0; cc < 16; ++cc) { const cf z = cmul(lp, bt[cc]); vr[cc] = z.re; vi[cc] = z.im; }
#pragma unroll
                        for (int h = 0; h < 2; ++h) {
                            u32x4 o; o.x = pk2(vr[8 * h + 0], vr[8 * h + 1]); o.y = pk2(vr[8 * h + 2], vr[8 * h + 3]); o.z = pk2(vr[8 * h + 4], vr[8 * h + 5]); o.w = pk2(vr[8 * h + 6], vr[8 * h + 7]);
                            *(u32x4*)(wre + j * 16 + 8 * h) = o;
                            o.x = pk2(vi[8 * h + 0], vi[8 * h + 1]); o.y = pk2(vi[8 * h + 2], vi[8 * h + 3]); o.z = pk2(vi[8 * h + 4], vi[8 * h + 5]); o.w = pk2(vi[8 * h + 6], vi[8 * h + 7]);
                            *(u32x4*)(wim + j * 16 + 8 * h) = o; }
                    }
                } else {
                    cf cv[16];
#pragma unroll
                    for (int c = 0; c < 16; ++c) { const size_t ci = ((size_t)(dir * NG + g) * 16 + c) * 64 + pp; cv[c] = cf{c_re[ci], c_im[ci]}; }
                    for (int ii = 4 * jq; ii < 4 * jq + 4; ++ii) {
                        const cf lp = lam_pow(a, brev, dir == 0 ? (float)(ii + 1) : (float)(TCH - ii));
#pragma unroll
                        for (int c = 0; c < 16; ++c) { const cf z = cmul(cv[c], lp);
                            bf16_t* kr = KW + ((size_t)g * 512 + ii * 16 + c) * 768 + 512 + dir * 128 + pp;
                            kr[0] = (bf16_t)f2bf(z.re); kr[64] = (bf16_t)f2bf(-z.im); }
                    }
                }
            }
        }
    }
    xcd_barrier(xbar);
    if (p.ws == nullptr) grid.sync();

    PH_ON(1) {
        for (int i = gt; i < NG * 512 * 64; i += NGT) {
            const int c8 = i & 1, j = (i >> 1) & 31, c = (i >> 6) & 15, ii = (i >> 10) & 31, g = i >> 15;
            float v[8];
            if (j < ii) { const float* s = KT + (((size_t)(g * 2 + 0) * TCH + (ii - j)) * 16 + c) * 16 + 8 * c8;
#pragma unroll
                for (int e = 0; e < 8; ++e) v[e] = s[e]; }
            else if (j > ii) { const float* s = KT + (((size_t)(g * 2 + 1) * TCH + (j - ii)) * 16 + c) * 16 + 8 * c8;
#pragma unroll
                for (int e = 0; e < 8; ++e) v[e] = s[e]; }
            else { const float* s0 = KT + (((size_t)(g * 2 + 0) * TCH) * 16 + c) * 16 + 8 * c8; const float* s1 = KT + (((size_t)(g * 2 + 1) * TCH) * 16 + c) * 16 + 8 * c8;
#pragma unroll
                for (int e = 0; e < 8; ++e) v[e] = s0[e] + s1[e] + ((8 * c8 + e) == c ? ssm_d[g * 16 + c] : 0.f); }
            u32x4 o; o.x = pk2(v[0], v[1]); o.y = pk2(v[2], v[3]); o.z = pk2(v[4], v[5]); o.w = pk2(v[6], v[7]);
            *(u32x4*)(KW + ((size_t)g * 512 + ii * 16 + c) * 768 + j * 16 + 8 * c8) = o;
        }
        pg8::Gemm g{XN, Win, DM, DM, DM, 0, 0}; pg8::StaticOrder S; S.init(MROWS, 2048, G, bid);
        EpiInProj E{CQ, CKV, UG, KRB, rsq_q, rsq_kv, ROPE};
        pg8::gemm_phase<EpiInProj, pg8::StaticOrder>(ldsl, g, S, E);
    }
    xcd_barrier(xbar);

    PH_ON(2) {
        for (int i = gt; i < MROWS * 8; i += NGT) { const int row = i >> 3, c = (i & 7) * 8; *(u32x4*)(KV + (size_t)row * 2112 + 2048 + c) = *(const u32x4*)(KRB + (size_t)row * 64 + c); }
#ifndef NO_SG
        { pg8::Gemm g{UG, Wst, 768, 512, 512, (long)NCHUNK * 768, 256L * 512}; pg8::GroupOrder S; S.init(NCHUNK / 256, 1, NG, G, bid); EpiS E{SBUF};
          pg8::gemm_phase<EpiS, pg8::GroupOrder>(ldsl, g, S, E); }
#endif
#ifndef NO_QB
        { pg8::Gemm g{CQ, Wqb, 512, 512, 512, 0, 0}; pg8::StaticOrder S; S.init(MROWS, 1536, G, G - 1 - bid);     EpiQ E{QBUF, rsq_q, ROPE};
          pg8::gemm_phase<EpiQ, pg8::StaticOrder>(ldsl, g, S, E); }
#endif
#ifndef NO_KVB
        { pg8::Gemm g{CKV, Wkvb, 256, 256, 256, 0, 0}; pg8::StaticOrder S; S.init(MROWS, 2048, G, bid); EpiScaleRow E{KV, 2112, rsq_kv, 1.f / 256.f};
          pg8::gemm_phase<EpiScaleRow, pg8::StaticOrder>(ldsl, g, S, E); }
#endif
    }
    xcd_barrier(xbar);

    PH_ON(3) {
        for (int slot = 0; slot < 2; ++slot) {
            int it;
            if (bid < 128) { if (slot) break; it = bid; } else { it = 128 + (bid - 128) * 2 + slot; }
            if (it < 128) scan_item<64>(p, ws, (LASP float*)ldsl, 2, it >> 1, it & 1, wave, lane);
            else { const int r = it - 128; scan_item<16>(p, ws, (LASP float*)ldsl, r >> 7, (r & 127) >> 1, r & 1, wave, lane); }
            __syncthreads();
        }
    }
    xcd_barrier(xbar);

    PH_ON(4) {
        pg8::Gemm g{UG, KW, 768, 768, 768, (long)NCHUNK * 768, 512L * 768}; pg8::GroupOrder S; S.init(NCHUNK / 256, 2, NG, G, bid); EpiY E{Yb};
        pg8::gemm_phase<EpiY, pg8::GroupOrder>(ldsl, g, S, E);
        if (bid >= 128) ffn_weight_items(p, ws, ldsl, 0, 8448, bid, wave, lane);
    }
    xcd_barrier(xbar);

    PH_ON(5) {
#ifndef NO_GLU
        { pg8::Gemm g{Yb, Wglu, 1024, 1024, 1024, 0, 0}; pg8::StaticOrder S; S.init(MROWS, 1024, G, bid); EpiGlu E{Yb, p.in[17], MIX, rsq_s};
          pg8::gemm_phase<EpiGlu, pg8::StaticOrder>(ldsl, g, S, E); }
#endif
        if (bid >= 128) ffn_weight_items(p, ws, ldsl, 8448, 16896, bid, wave, lane);
        __syncthreads();
        const int h = bid & 7, idx = bid >> 3;
#ifndef NO_ATT
        for (int rep = 0; rep < ATT_REP; ++rep)
        for (int uu = 0; uu < 3; ++uu) {
            int row0, qb, seq;
            if (uu < 2) { row0 = MPROMPT; seq = LS; qb = (idx * 2 + uu) % 64; if (idx >= 32) {   } }
            else { row0 = (idx >> 4) * LP; seq = LP; qb = idx & 15; }
            if (G == 256 || true) {
                const bf16_t* Qp = QBUF + (size_t)(row0 + qb * 256) * 1536 + h * QKD;
                const bf16_t* Kp = KV + (size_t)row0 * 2112;
                bf16_t* Op = MIX + (size_t)(row0 + qb * 256) * 2048 + h * 128;
                att::attn_body(Qp, Kp, h * 256, Op, rsq_a + row0 + qb * 256, seq, (char*)lds);
                __syncthreads();
            }
        }
#endif
    }
    xcd_barrier(xbar);

    PH_ON(7) {
        pg8::Gemm g{MIX, Wout, DM, DM, DM, 0, 0}; pg8::StaticOrder S; S.init(MROWS, DM, G, bid); EpiOutProj E{MB, rsq_a, rsq_s};
        pg8::gemm_phase<EpiOutProj, pg8::StaticOrder>(ldsl, g, S, E);
    }
    xcd_barrier(xbar);

    PH_ON(8) {
        const float* gpo = p.in[21];
        for (int m = gw; m < MROWS; m += NGW) {
            const u32x2* r8 = (const u32x2*)(MB + (size_t)m * DM) + lane; const f32x4* xr = (const f32x4*)xrow_ptr(p, m) + lane; f32x4 v[8]; float s = 0.f;
#pragma unroll
            for (int j = 0; j < 8; ++j) { const u32x2 w = r8[64 * j]; v[j] = (f32x4){__uint_as_float(w.x << 16), __uint_as_float(w.x & 0xffff0000u), __uint_as_float(w.y << 16), __uint_as_float(w.y & 0xffff0000u)};
                s += (v[j].x * v[j].x + v[j].y * v[j].y) + (v[j].z * v[j].z + v[j].w * v[j].w); }
            const float rm = 1.f / sqrtf(wave_sum(s) * (1.f / DM) + RMS_EPS); float s1 = 0.f;
            u32x2* h8 = (u32x2*)(Hb + (size_t)m * DM) + lane;
#pragma unroll
            for (int j = 0; j < 8; ++j) { const f32x4 gg = *(const f32x4*)(gpo + 4 * lane + 256 * j); v[j] = xr[64 * j] + v[j] * rm * gg;
                s1 += (v[j].x * v[j].x + v[j].y * v[j].y) + (v[j].z * v[j].z + v[j].w * v[j].w);
                u32x2 o; o.x = pk2(v[j].x, v[j].y); o.y = pk2(v[j].z, v[j].w); h8[64 * j] = o; }
            s1 = wave_sum(s1);
            if (lane == 0) rsq_x[m] = s1;
        }
    }
    xcd_barrier(xbar);

    PH_ON(9) {
        pg8::Gemm g{Hb, Wgu, DM, DM, DM, 0, 0}; pg8::StaticOrder S; S.init(MROWS, 2 * DFF, G, bid); EpiFfn E{HMID, rsq_x};
        for (int frep = 0; frep < FFN_REP; ++frep) pg8::gemm_phase<EpiFfn, pg8::StaticOrder>(ldsl, g, S, E);
    }
    xcd_barrier(xbar);

    PH_ON(10) {
        pg8::Gemm g{HMID, Wdown, DFF, DFF, DFF, 0, 0}; pg8::StaticOrder S; S.init(MROWS, DM, G, bid); EpiScaleRow E{(bf16_t*)p.out, 2 * DM, nullptr, 0.f};
        for (int frep = 0; frep < FFN_REP; ++frep) pg8::gemm_phase<EpiScaleRow, pg8::StaticOrder>(ldsl, g, S, E);
    }
    xcd_barrier(xbar);

    PH_ON(11) {
        const float* gpf = p.in[26];
        for (int m = gw; m < MROWS; m += NGW) {
            const u32x2* r8 = (const u32x2*)((const bf16_t*)p.out + (size_t)m * 2 * DM) + lane; const u32x2* x8 = (const u32x2*)(Hb + (size_t)m * DM) + lane; f32x4 v[8]; u32x2 xb[8]; float s = 0.f;
#pragma unroll
            for (int j = 0; j < 8; ++j) { const u32x2 w = r8[64 * j]; xb[j] = x8[64 * j]; v[j] = (f32x4){__uint_as_float(w.x << 16), __uint_as_float(w.x & 0xffff0000u), __uint_as_float(w.y << 16), __uint_as_float(w.y & 0xffff0000u)};
                s += (v[j].x * v[j].x + v[j].y * v[j].y) + (v[j].z * v[j].z + v[j].w * v[j].w); }
            const float rf = 1.f / sqrtf(wave_sum(s) * (1.f / DM) + RMS_EPS);
            f32x4* orow = (f32x4*)(p.out + (size_t)m * DM) + lane;
#pragma unroll
            for (int j = 0; j < 8; ++j) { const f32x4 gg = *(const f32x4*)(gpf + 4 * lane + 256 * j);
                const f32x4 x1 = (f32x4){__uint_as_float(xb[j].x << 16), __uint_as_float(xb[j].x & 0xffff0000u), __uint_as_float(xb[j].y << 16), __uint_as_float(xb[j].y & 0xffff0000u)};
                orow[64 * j] = x1 + v[j] * rf * gg; }
        }
    }
}

extern "C" void kernel_launch(void* const* d_in, const int* in_sizes, int n_in, void* d_out, int out_size, void* d_ws, size_t ws_size, hipStream_t stream) {
    static int grid = 0;
    if (grid == 0) {
        if (n_in != 27 || ws_size < WS_END) { fprintf(stderr, "kernel_launch: unexpected n_in %d / ws_size %zu\n", n_in, ws_size); grid = -1; return; }
        int dev = 0, cus = 0, per_cu = 0;
        hipGetDevice(&dev); hipDeviceGetAttribute(&cus, hipDeviceAttributeMultiprocessorCount, dev);
        hipFuncSetAttribute((const void*)fwd_megakernel, hipFuncAttributeMaxDynamicSharedMemorySize, LDS_BYTES);
        hipOccupancyMaxActiveBlocksPerMultiprocessor(&per_cu, (const void*)fwd_megakernel, 512, LDS_BYTES);
        if (per_cu < 1) { fprintf(stderr, "kernel_launch: occupancy query says %d blocks per CU\n", per_cu); per_cu = 1; }
        (void)hipGetLastError();
        grid = 256;
        if (cus < 256) fprintf(stderr, "kernel_launch: %d CUs (built for 256): the cooperative launch will be rejected\n", cus);
    }
    if (grid < 0) return;
    Params p{};
    for (int i = 0; i < 27; ++i) p.in[i] = (const float*)d_in[i];
    p.out = (float*)d_out; p.ws = (unsigned char*)d_ws;
    (void)hipMemsetAsync((char*)d_ws + WS_BAR, 0, BAR_BYTES, stream);
    void* args[] = {&p};
    hipError_t e = hipLaunchCooperativeKernel((const void*)fwd_megakernel, dim3(grid), dim3(512), args, LDS_BYTES, stream);
    if (e != hipSuccess) fprintf(stderr, "cooperative launch failed: %s (grid %d)\n", hipGetErrorString(e), grid);
}
```
